# Optimizing an MI355X kernel written in HIP

```python
import jax, jax.numpy as jnp
from jax import lax
import numpy as np

D_MODEL = 1024
BATCH = 8
SEQ = 4096
DEPTH = 4

CHUNK = 64
HEAD_DIM = 64
SB_HEADS = 8
CA_HEADS = 8
LEFT_CHUNKS = 8
REL_CLIP = 256
QBLOCK = 128
SB_W = SB_HEADS * HEAD_DIM
CA_W = CA_HEADS * HEAD_DIM
MIX_WIDTH = SB_W + CA_W
ML_HEADS = 4
ML_QK_DIM = 128
ML_V_DIM = D_MODEL // ML_HEADS
ML_QK_W = ML_HEADS * ML_QK_DIM
ML_V_W = ML_HEADS * ML_V_DIM
ML_IN_W = 2 * ML_QK_W + 2 * ML_V_W + 2 * ML_HEADS
CONV_K = 4
GATE_SOFTCAP = 15.0
D_FF = 2816
N_EXPERTS = 8
TOP_K = 2
D_FF_EXPERT = 3584
N_EVEN = (DEPTH + 1) // 2
N_ODD = DEPTH // 2
EPS = 1e-6

kernel_name = "chunk_causal_hybrid_sb_band_mlstm_moe"


def rmsnorm(x, g):
    xf = x.astype(jnp.float32)
    y = xf * lax.rsqrt(jnp.mean(xf * xf, axis=-1, keepdims=True) + EPS)
    return (y * g.astype(jnp.float32)).astype(x.dtype)


def split_heads(t, n_heads):
    b, s, _ = t.shape
    return t.reshape(b, s, n_heads, -1).transpose(0, 2, 1, 3)


def swiglu(x, wg, wu, wd):
    return (jax.nn.silu(x @ wg) * (x @ wu)) @ wd


def stick_breaking_attention(q, k, v):
    seq, d = q.shape[2], q.shape[3]
    scale = d ** -0.5
    outs = []
    for blk in range(seq // QBLOCK):
        q0 = blk * QBLOCK
        kend = q0 + QBLOCK
        qb = q[:, :, q0:kend].astype(jnp.float32)
        kb = k[:, :, :kend].astype(jnp.float32)
        vb = v[:, :, :kend].astype(jnp.float32)
        z = jnp.einsum('bhqd,bhkd->bhqk', qb, kb) * scale
        t_pos = q0 + jnp.arange(QBLOCK)[:, None]
        s_pos = jnp.arange(kend)[None, :]
        valid = s_pos < t_pos
        log_1mb = jnp.where(valid, jax.nn.log_sigmoid(-z), 0.0)
        between = lax.cumsum(log_1mb, axis=3, reverse=True) - log_1mb
        w = jnp.where(valid, jnp.exp(jax.nn.log_sigmoid(z) + between), 0.0)
        outs.append(jnp.einsum('bhqk,bhkd->bhqd', w, vb))
    return jnp.concatenate(outs, axis=2).astype(v.dtype)


def chunked_band_attention(q, k, v, rel_bias):
    b, h, seq, d = q.shape
    n_chunks = seq // CHUNK
    pad = LEFT_CHUNKS * CHUNK
    band = (LEFT_CHUNKS + 1) * CHUNK
    kp = jnp.pad(k, ((0, 0), (0, 0), (pad, 0), (0, 0)))
    vp = jnp.pad(v, ((0, 0), (0, 0), (pad, 0), (0, 0)))
    tq = jnp.arange(CHUNK)[:, None]
    jk = jnp.arange(band)[None, :]
    rel = tq + pad - jk
    bias = rel_bias[:, jnp.clip(rel, -REL_CLIP, REL_CLIP) + REL_CLIP].astype(jnp.float32)
    scale = d ** -0.5

    def one_chunk(c):
        qc = lax.dynamic_slice_in_dim(q, c * CHUNK, CHUNK, axis=2).astype(jnp.float32)
        kc = lax.dynamic_slice_in_dim(kp, c * CHUNK, band, axis=2).astype(jnp.float32)
        vc = lax.dynamic_slice_in_dim(vp, c * CHUNK, band, axis=2).astype(jnp.float32)
        s = jnp.einsum('bhqd,bhkd->bhqk', qc, kc) * scale + bias
        valid = jk >= pad - c * CHUNK
        p = jax.nn.softmax(jnp.where(valid, s, -jnp.inf), axis=-1)
        return jnp.einsum('bhqk,bhkd->bhqd', p, vc)

    out = lax.map(one_chunk, jnp.arange(n_chunks))
    return out.transpose(1, 2, 0, 3, 4).reshape(b, h, seq, d).astype(v.dtype)


def even_mixer(xn, w_in, rel_bias, w_out):
    b, s, _ = xn.shape
    u = xn @ w_in
    qa, ka, va, qb, kb, vb = jnp.split(
        u, [SB_W, 2 * SB_W, 3 * SB_W, 3 * SB_W + CA_W, 3 * SB_W + 2 * CA_W], axis=-1)
    oa = stick_breaking_attention(split_heads(qa, SB_HEADS), split_heads(ka, SB_HEADS),
                                  split_heads(va, SB_HEADS))
    ob = chunked_band_attention(split_heads(qb, CA_HEADS), split_heads(kb, CA_HEADS),
                                split_heads(vb, CA_HEADS), rel_bias)
    o = jnp.concatenate([oa, ob], axis=1)
    o = o.transpose(0, 2, 1, 3).reshape(b, s, MIX_WIDTH)
    return o @ w_out


def causal_depthwise_conv(x, w, bias):
    c = x.shape[-1]
    y = lax.conv_general_dilated(
        x, w.reshape(CONV_K, 1, c), window_strides=(1,), padding=[(CONV_K - 1, 0)],
        dimension_numbers=('NWC', 'WIO', 'NWC'), feature_group_count=c)
    return y + bias


def mlstm_chunk_step(carry, inp):
    c_mat, n_vec, m_prev = carry
    q, k, v, log_i, log_f = inp
    L = q.shape[2]
    causal = jnp.arange(L)[:, None] >= jnp.arange(L)[None, :]
    bcum = jnp.cumsum(log_f, axis=-1)
    dmat = jnp.where(causal, bcum[..., :, None] - bcum[..., None, :] + log_i[..., None, :], -jnp.inf)
    inter = bcum + m_prev[..., None]
    m_t = jnp.maximum(inter, jnp.max(dmat, axis=-1))
    scores = jnp.einsum('bhtd,bhsd->bhts', q, k) * jnp.exp(dmat - m_t[..., None])
    inter_scale = jnp.exp(inter - m_t)
    num = (jnp.einsum('bhts,bhsv->bhtv', scores, v)
           + inter_scale[..., None] * jnp.einsum('bhtd,bhdv->bhtv', q, c_mat))
    den = jnp.sum(scores, axis=-1) + inter_scale * jnp.einsum('bhtd,bhd->bht', q, n_vec)
    h = num / jnp.maximum(jnp.abs(den), jnp.exp(-m_t))[..., None]
    g = bcum[..., -1]
    decay_s = g[..., None] - bcum + log_i
    m_new = jnp.maximum(g + m_prev, jnp.max(decay_s, axis=-1))
    ws = jnp.exp(decay_s - m_new[..., None])
    carry_scale = jnp.exp(g + m_prev - m_new)
    c_new = carry_scale[..., None, None] * c_mat + jnp.einsum('bhs,bhsd,bhsv->bhdv', ws, k, v)
    n_new = carry_scale[..., None] * n_vec + jnp.einsum('bhs,bhsd->bhd', ws, k)
    return (c_new, n_new, m_new), h


def mlstm_mixer(xn, w_in, conv_w, conv_b, b_i, b_f, mh_g, w_out):
    b, s, _ = xn.shape
    n_chunks = s // CHUNK
    u = xn @ w_in
    qk, v, o_pre, gates = jnp.split(u, [2 * ML_QK_W, 2 * ML_QK_W + ML_V_W, 2 * ML_QK_W + 2 * ML_V_W], axis=-1)
    qk = jax.nn.silu(causal_depthwise_conv(qk, conv_w, conv_b))
    q, k = jnp.split(qk.astype(jnp.float32), 2, axis=-1)
    k = k * (ML_QK_DIM ** -0.5)
    gf = gates.astype(jnp.float32)
    i_pre = GATE_SOFTCAP * jnp.tanh((gf[..., :ML_HEADS] + b_i) / GATE_SOFTCAP)
    f_pre = GATE_SOFTCAP * jnp.tanh((gf[..., ML_HEADS:] + b_f) / GATE_SOFTCAP)
    log_i = i_pre
    log_f = jax.nn.log_sigmoid(f_pre)

    def to_chunks(t):
        return t.reshape(b, n_chunks, CHUNK, ML_HEADS, -1).transpose(1, 0, 3, 2, 4)

    def gate_chunks(t):
        return t.reshape(b, n_chunks, CHUNK, ML_HEADS).transpose(1, 0, 3, 2)

    xs = (to_chunks(q.reshape(b, s, ML_HEADS, ML_QK_DIM)),
          to_chunks(k.reshape(b, s, ML_HEADS, ML_QK_DIM)),
          to_chunks(v.astype(jnp.float32).reshape(b, s, ML_HEADS, ML_V_DIM)),
          gate_chunks(log_i), gate_chunks(log_f))
    init = (jnp.zeros((b, ML_HEADS, ML_QK_DIM, ML_V_DIM), jnp.float32),
            jnp.zeros((b, ML_HEADS, ML_QK_DIM), jnp.float32),
            jnp.zeros((b, ML_HEADS), jnp.float32))
    _, h = lax.scan(mlstm_chunk_step, init, xs)
    h = h.transpose(1, 0, 3, 2, 4).reshape(b, s, ML_HEADS, ML_V_DIM)
    h = h * lax.rsqrt(jnp.mean(h * h, axis=-1, keepdims=True) + EPS)
    h = h * mh_g.astype(jnp.float32).reshape(ML_HEADS, ML_V_DIM)
    h = (jax.nn.sigmoid(o_pre.astype(jnp.float32)) * h.reshape(b, s, ML_V_W)).astype(xn.dtype)
    return h @ w_out


def moe_swiglu(xn, w_router, wg, wu, wd):
    b, s, d = xn.shape
    xt = xn.reshape(b * s, d)
    logits = (xt @ w_router).astype(jnp.float32)
    top_val, top_idx = lax.top_k(logits, TOP_K)
    top_w = jax.nn.softmax(top_val, axis=-1)
    gate = jnp.sum(jax.nn.one_hot(top_idx, N_EXPERTS, dtype=jnp.float32) * top_w[..., None], axis=1)
    y = jnp.zeros_like(xt)
    for e in range(N_EXPERTS):
        y = y + gate[:, e:e + 1].astype(xt.dtype) * swiglu(xt, wg[e], wu[e], wd[e])
    return y.reshape(b, s, d)


def setup_inputs(seed: int = 0) -> dict:
    key = jax.random.key(seed)
    ks = jax.random.split(key, 24)
    f32 = jnp.float32

    def nrm(k, shape, fan_in):
        return jax.random.normal(k, shape, f32) * (fan_in ** -0.5)

    def gain(k, shape):
        return 1.0 + 0.02 * jax.random.normal(k, shape, f32)

    return {
        "x": jax.random.normal(ks[0], (BATCH, SEQ, D_MODEL), f32),
        "mix_norm_even": gain(ks[1], (N_EVEN, D_MODEL)),
        "w_in_attn": nrm(ks[2], (N_EVEN, D_MODEL, 3 * MIX_WIDTH), D_MODEL),
        "rel_bias": 0.2 * jax.random.normal(ks[3], (N_EVEN, CA_HEADS, 2 * REL_CLIP + 1), f32),
        "w_out_attn": nrm(ks[4], (N_EVEN, MIX_WIDTH, D_MODEL), MIX_WIDTH),
        "ffn_norm_even": gain(ks[5], (N_EVEN, D_MODEL)),
        "w_dense_gate": nrm(ks[6], (N_EVEN, D_MODEL, D_FF), D_MODEL),
        "w_dense_up": nrm(ks[7], (N_EVEN, D_MODEL, D_FF), D_MODEL),
        "w_dense_down": nrm(ks[8], (N_EVEN, D_FF, D_MODEL), D_FF),
        "mix_norm_odd": gain(ks[9], (N_ODD, D_MODEL)),
        "w_in_mlstm": nrm(ks[10], (N_ODD, D_MODEL, ML_IN_W), D_MODEL),
        "conv_w": nrm(ks[11], (N_ODD, CONV_K, 2 * ML_QK_W), CONV_K),
        "conv_b": 0.02 * jax.random.normal(ks[12], (N_ODD, 2 * ML_QK_W), f32),
        "b_igate": 0.1 * jax.random.normal(ks[13], (N_ODD, ML_HEADS), f32),
        "b_fgate": jnp.linspace(3.0, 6.0, ML_HEADS, dtype=f32)[None, :]
                   + 0.1 * jax.random.normal(ks[14], (N_ODD, ML_HEADS), f32),
        "mh_norm_g": gain(ks[15], (N_ODD, ML_V_W)),
        "w_out_mlstm": nrm(ks[16], (N_ODD, ML_V_W, D_MODEL), ML_V_W),
        "ffn_norm_odd": gain(ks[17], (N_ODD, D_MODEL)),
        "w_router": nrm(ks[18], (N_ODD, D_MODEL, N_EXPERTS), D_MODEL),
        "w_exp_gate": nrm(ks[19], (N_ODD, N_EXPERTS, D_MODEL, D_FF_EXPERT), D_MODEL),
        "w_exp_up": nrm(ks[20], (N_ODD, N_EXPERTS, D_MODEL, D_FF_EXPERT), D_MODEL),
        "w_exp_down": nrm(ks[21], (N_ODD, N_EXPERTS, D_FF_EXPERT, D_MODEL), D_FF_EXPERT),
        "final_norm_g": gain(ks[22], (D_MODEL,)),
    }


def reference(x, mix_norm_even, w_in_attn, rel_bias, w_out_attn, ffn_norm_even,
              w_dense_gate, w_dense_up, w_dense_down, mix_norm_odd, w_in_mlstm,
              conv_w, conv_b, b_igate, b_fgate, mh_norm_g, w_out_mlstm, ffn_norm_odd,
              w_router, w_exp_gate, w_exp_up, w_exp_down, final_norm_g):
    h = x
    for layer in range(DEPTH):
        j = layer // 2
        if layer % 2 == 0:
            h = h + even_mixer(rmsnorm(h, mix_norm_even[j]), w_in_attn[j], rel_bias[j], w_out_attn[j])
            h = h + swiglu(rmsnorm(h, ffn_norm_even[j]), w_dense_gate[j], w_dense_up[j], w_dense_down[j])
        else:
            h = h + mlstm_mixer(rmsnorm(h, mix_norm_odd[j]), w_in_mlstm[j], conv_w[j], conv_b[j],
                                b_igate[j], b_fgate[j], mh_norm_g[j], w_out_mlstm[j])
            h = h + moe_swiglu(rmsnorm(h, ffn_norm_odd[j]), w_router[j], w_exp_gate[j],
                               w_exp_up[j], w_exp_down[j])
    return rmsnorm(h, final_norm_g)
```

```cpp
#define MK_PER_PHASE 0
#include <hip/hip_runtime.h>
#include <cstdio>
#include <cstdint>
#include <cmath>
namespace pg8 {
#define PG8_LAS __attribute__((address_space(3)))
typedef unsigned short bf16_t;
typedef short bf16x8 __attribute__((ext_vector_type(8)));
typedef float f32x4 __attribute__((ext_vector_type(4)));
typedef unsigned u32x4 __attribute__((ext_vector_type(4)));
typedef int i32x4 __attribute__((ext_vector_type(4)));
typedef int i32x8 __attribute__((ext_vector_type(8)));
constexpr int BM = 256, BK = 64, HALF = 128, HTB = HALF * BK * 2  , STAGE_BYTES = 8 * HTB, NXCD = 8, WGM = 8;

__host__ __device__ __forceinline__ int lds_byte(int r, int c) { const int st = (r >> 4) * 2 + (c >> 5), rr = r & 15, cc = c & 31, ob = rr * 64 + cc * 2; return st * 1024 + (ob ^ (((ob >> 9) & 1) << 5)); }
__host__ __device__ __forceinline__ void stage_rc(int b, int& R, int& C) { const int st = b / 1024, sb = b % 1024, swz = sb ^ (((sb >> 9) & 1) << 5); R = (st >> 1) * 16 + swz / 64; C = (st & 1) * 32 + (swz % 64) / 2; }
__host__ __device__ __forceinline__ int perm32(int rho) { const int n = rho >> 4, i = rho & 15; return 8 * (i >> 2) + 4 * n + (i & 3); }

struct Unit { int pm, pn, pc; };
struct Gemm { const bf16_t* A; const bf16_t* Bt; int M, N, K; };

struct StaticOrder {
    int nM, nN, nwg, G, c;
    __host__ __device__ void init(int M, int N, int G_, int c_) { nM = M / BM; nN = N / BM; nwg = nM * nN; G = G_; c = c_; }
    __host__ __device__ bool next(int i, Unit& u) const {
        const long L = (long)i * G + c; if (L >= nwg) return false;
        int wgid = (int)L; { const int q = nwg / NXCD, r = nwg % NXCD, xcd = wgid % NXCD, off = wgid / NXCD; wgid = (xcd < r ? xcd * (q + 1) : r * (q + 1) + (xcd - r) * q) + off; }
        const int nig = WGM * nN, gid = wgid / nig, fm = gid * WGM, gsz = (nM - fm) < WGM ? (nM - fm) : WGM;
        u.pm = fm + ((wgid % nig) % gsz); u.pn = (wgid % nig) / gsz; u.pc = u.pn; return true;
    }
    __device__ __forceinline__ void a_ready(const Unit&) const {}
    __device__ __forceinline__ void done(const Unit&) const {}
};

__device__ __forceinline__ unsigned cvt_pk_bf16(float lo, float hi) { unsigned r; asm volatile("v_cvt_pk_bf16_f32 %0, %1, %2" : "=v"(r) : "v"(lo), "v"(hi)); return r; }
typedef float f32x2 __attribute__((ext_vector_type(2)));
__device__ __forceinline__ float silu_f(float x) { return x * __builtin_amdgcn_rcpf(1.0f + __expf(-x)); }
struct EpiStoreBf16 {
    static constexpr bool PERM = true, AFTER_DRAIN = false;
    bf16_t* O; int ldc;
    __device__ __forceinline__ void operator()(const f32x4 (&acc)[2][2][4][2], const Unit& u, int wr, int wc, int fr, int fq) const {
        const int row0 = u.pm * BM + wr * 64 + fr, col0 = u.pc * BM + wc * 32 + 8 * fq;
#pragma unroll
        for (int ai = 0; ai < 2; ++ai)
#pragma unroll
            for (int m = 0; m < 4; ++m) { bf16_t* rowp = O + (size_t)(row0 + ai * HALF + m * 16) * ldc + col0;
#pragma unroll
                for (int bj = 0; bj < 2; ++bj) { const f32x4 v0 = acc[ai][bj][m][0], v1 = acc[ai][bj][m][1];
                    u32x4 w; w.x = cvt_pk_bf16(v0[0], v0[1]); w.y = cvt_pk_bf16(v0[2], v0[3]); w.z = cvt_pk_bf16(v1[0], v1[1]); w.w = cvt_pk_bf16(v1[2], v1[3]);
                    *(u32x4*)(rowp + bj * HALF) = w; } }
    }
};
struct EpiStoreTiled {
    static constexpr bool PERM = true, AFTER_DRAIN = false;
    bf16_t* O; int nrt; float scale = 1.0f;
    __device__ __forceinline__ void operator()(const f32x4 (&acc)[2][2][4][2], const Unit& u, int wr, int wc, int fr, int fq) const {
        const int row0 = u.pm * BM + wr * 64 + fr, col0 = u.pc * BM + wc * 32 + 8 * fq;
#pragma unroll
        for (int ai = 0; ai < 2; ++ai)
#pragma unroll
            for (int m = 0; m < 4; ++m) { const int row = row0 + ai * HALF + m * 16;
#pragma unroll
                for (int bj = 0; bj < 2; ++bj) { const int col = col0 + bj * HALF; const f32x4 v0 = acc[ai][bj][m][0] * scale, v1 = acc[ai][bj][m][1] * scale;
                    u32x4 w; w.x = cvt_pk_bf16(v0[0], v0[1]); w.y = cvt_pk_bf16(v0[2], v0[3]); w.z = cvt_pk_bf16(v1[0], v1[1]); w.w = cvt_pk_bf16(v1[2], v1[3]);
                    *(u32x4*)(O + ((size_t)(col >> 4) * nrt + (row >> 5)) * 512 + ((row & 31) + 32 * ((col >> 3) & 1)) * 8) = w; } }
    }
};
template <bool BF32> struct EpiResidH {
    static constexpr bool PERM = true, AFTER_DRAIN = false;
    const void* base; bf16_t* out; int ldc; float scale;
    __device__ __forceinline__ void operator()(const f32x4 (&acc)[2][2][4][2], const Unit& u, int wr, int wc, int fr, int fq) const {
        const int row0 = u.pm * BM + wr * 64 + fr, col0 = u.pc * BM + wc * 32 + 8 * fq;
#pragma unroll
        for (int ai = 0; ai < 2; ++ai)
#pragma unroll
            for (int m = 0; m < 4; ++m) { const size_t off = (size_t)(row0 + ai * HALF + m * 16) * ldc + col0;
#pragma unroll
                for (int bj = 0; bj < 2; ++bj) { f32x4 v0 = acc[ai][bj][m][0] * scale, v1 = acc[ai][bj][m][1] * scale;
                    if constexpr (BF32) { const float* bp = (const float*)base + off + bj * HALF; v0 += *(const f32x4*)bp; v1 += *(const f32x4*)(bp + 4); }
                    else { const u32x4 b = *(const u32x4*)((const bf16_t*)base + off + bj * HALF);
                        v0[0] += __builtin_bit_cast(float, b.x << 16); v0[1] += __builtin_bit_cast(float, b.x & 0xffff0000u); v0[2] += __builtin_bit_cast(float, b.y << 16); v0[3] += __builtin_bit_cast(float, b.y & 0xffff0000u);
                        v1[0] += __builtin_bit_cast(float, b.z << 16); v1[1] += __builtin_bit_cast(float, b.z & 0xffff0000u); v1[2] += __builtin_bit_cast(float, b.w << 16); v1[3] += __builtin_bit_cast(float, b.w & 0xffff0000u); }
                    u32x4 w; w.x = cvt_pk_bf16(v0[0], v0[1]); w.y = cvt_pk_bf16(v0[2], v0[3]); w.z = cvt_pk_bf16(v1[0], v1[1]); w.w = cvt_pk_bf16(v1[2], v1[3]);
                    *(u32x4*)(out + off + bj * HALF) = w; } }
    }
};
struct EpiSwiGLU {
    static constexpr bool PERM = true, AFTER_DRAIN = false;
    bf16_t* O; int ldc;
    __device__ __forceinline__ void pk4(const f32x4 g, const f32x4 u, unsigned& lo, unsigned& hi) const {
        const f32x4 t = g * (-1.4426950408889634f), gu = g * u; float r[4];
#pragma unroll
        for (int i = 0; i < 4; ++i) r[i] = gu[i] * __builtin_amdgcn_rcpf(1.0f + __builtin_amdgcn_exp2f(t[i]));
        lo = cvt_pk_bf16(r[0], r[1]); hi = cvt_pk_bf16(r[2], r[3]);
    }
    __device__ __forceinline__ void operator()(const f32x4 (&acc)[2][2][4][2], const Unit& u, int wr, int wc, int fr, int fq) const {
        const int row0 = u.pm * BM + wr * 64 + fr, col0 = u.pc * HALF + wc * 32 + 8 * fq;
#pragma unroll
        for (int ai = 0; ai < 2; ++ai)
#pragma unroll
            for (int m = 0; m < 4; ++m) { bf16_t* rowp = O + (size_t)(row0 + ai * HALF + m * 16) * ldc + col0;
                unsigned w0, w1, w2, w3; pk4(acc[ai][0][m][0], acc[ai][1][m][0], w0, w1); pk4(acc[ai][0][m][1], acc[ai][1][m][1], w2, w3);
                *(u32x4*)rowp = (u32x4){w0, w1, w2, w3}; }
    }
};
__device__ __forceinline__ unsigned pk4_f8(float a, float b, float c, float d) {
    a = fminf(fmaxf(a, -448.f), 448.f); b = fminf(fmaxf(b, -448.f), 448.f); c = fminf(fmaxf(c, -448.f), 448.f); d = fminf(fmaxf(d, -448.f), 448.f);
    int w = __builtin_amdgcn_cvt_pk_fp8_f32(a, b, 0, false); w = __builtin_amdgcn_cvt_pk_fp8_f32(c, d, w, true); return (unsigned)w;
}
template <bool NT = false> struct EpiSwiGLUF8T_ {
    static constexpr bool PERM = true, AFTER_DRAIN = false;
    unsigned char* O; int ldc; float inv, osc;
    __device__ __forceinline__ unsigned pk4(const f32x4 g, const f32x4 u, float c1, float c2) const {
        const f32x4 t = g * c1, gu = (g * u) * c2; float r[4];
#pragma unroll
        for (int i = 0; i < 4; ++i) { const float s = __builtin_amdgcn_rcpf(1.0f + __builtin_amdgcn_exp2f(t[i])); r[i] = __builtin_amdgcn_fmed3f(gu[i] * s, -448.f, 448.f); }
        int w = __builtin_amdgcn_cvt_pk_fp8_f32(r[0], r[1], 0, false); w = __builtin_amdgcn_cvt_pk_fp8_f32(r[2], r[3], w, true); return (unsigned)w;
    }
    __device__ __forceinline__ void operator()(const f32x4 (&acc)[2][2][4][2], const Unit& u, int wr, int wc, int fr, int fq) const {
        const int row0 = u.pm * BM + wr * 64 + fr, col0 = u.pc * HALF + wc * 32 + 8 * fq;
        const float c1 = -inv * 1.4426950408889634f, c2 = inv * inv * osc;
#pragma unroll
        for (int ai = 0; ai < 2; ++ai)
#pragma unroll
            for (int m = 0; m < 4; ++m) { unsigned char* rowp = O + (size_t)(row0 + ai * HALF + m * 16) * ldc + col0;
                typedef unsigned u32x2 __attribute__((ext_vector_type(2))); u32x2 w;
                w.x = pk4(acc[ai][0][m][0], acc[ai][1][m][0], c1, c2); w.y = pk4(acc[ai][0][m][1], acc[ai][1][m][1], c1, c2);
                if constexpr (NT) __builtin_nontemporal_store(w, (u32x2*)rowp); else *(u32x2*)rowp = w; }
    }
};
typedef EpiSwiGLUF8T_<false> EpiSwiGLUF8; typedef EpiSwiGLUF8T_<true> EpiSwiGLUF8NT;
struct EpiStoreBf16S {
    static constexpr bool PERM = true, AFTER_DRAIN = false;
    bf16_t* O; int ldc; float scale;
    __device__ __forceinline__ void operator()(const f32x4 (&acc)[2][2][4][2], const Unit& u, int wr, int wc, int fr, int fq) const {
        const int row0 = u.pm * BM + wr * 64 + fr, col0 = u.pc * BM + wc * 32 + 8 * fq;
#pragma unroll
        for (int ai = 0; ai < 2; ++ai)
#pragma unroll
            for (int m = 0; m < 4; ++m) { bf16_t* rowp = O + (size_t)(row0 + ai * HALF + m * 16) * ldc + col0;
#pragma unroll
                for (int bj = 0; bj < 2; ++bj) { const f32x4 v0 = acc[ai][bj][m][0] * scale, v1 = acc[ai][bj][m][1] * scale;
                    u32x4 w; w.x = cvt_pk_bf16(v0[0], v0[1]); w.y = cvt_pk_bf16(v0[2], v0[3]); w.z = cvt_pk_bf16(v1[0], v1[1]); w.w = cvt_pk_bf16(v1[2], v1[3]);
                    *(u32x4*)(rowp + bj * HALF) = w; } }
    }
};
struct MoeOrder {
    int ntl, ncol, G, c, tile0; const PG8_LAS int* texp;
    __device__ __forceinline__ bool next(int i, Unit& u) const {
        const int nwg = ntl * ncol; int wgid = i * G + c; if (wgid >= nwg) return false;
        { const int q = nwg / NXCD, rr = nwg % NXCD, xcd = wgid % NXCD, off = wgid / NXCD; wgid = (xcd < rr ? xcd * (q + 1) : rr * (q + 1) + (xcd - rr) * q) + off; }
        const int nig = WGM * ncol, gid = wgid / nig, fm = gid * WGM, gsz = (ntl - fm) < WGM ? (ntl - fm) : WGM;
        const int pm = fm + ((wgid % nig) % gsz), pc = (wgid % nig) / gsz; const int e = __builtin_amdgcn_readfirstlane(texp[tile0 + pm]);
        u.pm = pm; u.pc = pc; u.pn = e * ncol + pc; return true;
    }
    __device__ __forceinline__ void a_ready(const Unit&) const {}
    __device__ __forceinline__ void done(const Unit&) const {}
};
template <unsigned long long LUT, int NN> struct LutOrder {
    int nM, nwg, G, c;
    __host__ __device__ void init(int M, int G_, int c_) { nM = M / BM; nwg = nM * NN; G = G_; c = c_; }
    __device__ __forceinline__ bool next(int i, Unit& u) const {
        const long L = (long)i * G + c; if (L >= nwg) return false;
        int wgid = (int)L; { const int q = nwg / NXCD, r = nwg % NXCD, xcd = wgid % NXCD, off = wgid / NXCD; wgid = (xcd < r ? xcd * (q + 1) : r * (q + 1) + (xcd - r) * q) + off; }
        const int nig = WGM * NN, gid = wgid / nig, fm = gid * WGM, gsz = (nM - fm) < WGM ? (nM - fm) : WGM;
        u.pm = fm + ((wgid % nig) % gsz); const int pn = (wgid % nig) / gsz; u.pn = (int)((LUT >> (4 * pn)) & 15ull); u.pc = u.pn; return true;
    }
    __device__ __forceinline__ void a_ready(const Unit&) const {}
    __device__ __forceinline__ void done(const Unit&) const {}
};
template <bool ML> struct EpiStoreVT {
    static constexpr bool PERM = false, AFTER_DRAIN = false;
    bf16_t* O; float scale;
    __device__ __forceinline__ void operator()(const f32x4 (&acc)[2][2][4][2], const Unit& u, int wr, int wc, int fr, int fq) const {
        const int pcv = ML ? u.pc - 4 : (u.pc < 6 ? u.pc - 4 : u.pc - 8);
        const int tb = u.pm * BM + wr * 64 + 8 * fq;
#pragma unroll
        for (int ai = 0; ai < 2; ++ai)
#pragma unroll
            for (int bj = 0; bj < 2; ++bj) { const int cb5 = pcv * 8 + bj * 4 + wc;
#pragma unroll
                for (int k = 0; k < 2; ++k) { const int t = tb + ai * HALF + 32 * k, b = t >> 12, tk = (t & 4095) >> 4;
                    const int idx = ML ? (b * 4 + (cb5 >> 3)) * 9 + (cb5 & 7) : b * 32 + cb5;
                    bf16_t* blk = O + ((size_t)idx * 256 + tk) * 512 + (32 * (fq & 1) + fr) * 8;
#pragma unroll
                    for (int n = 0; n < 2; ++n) { const f32x4 v0 = acc[ai][bj][2 * k][n] * scale, v1 = acc[ai][bj][2 * k + 1][n] * scale;
                        u32x4 w; w.x = cvt_pk_bf16(v0[0], v0[1]); w.y = cvt_pk_bf16(v0[2], v0[3]); w.z = cvt_pk_bf16(v1[0], v1[1]); w.w = cvt_pk_bf16(v1[2], v1[3]);
                        *(u32x4*)(blk + n * 128) = w; } } }
    }
};
template <class Epi, class Sched, bool ALIGN_EPI = false, bool SP2 = false, bool F8 = false, bool SWAP = false>
__device__ __forceinline__ void gemm_phase(PG8_LAS unsigned char* lds, const Gemm g, const Sched& S, const Epi& E) {
    int tid_ = threadIdx.x; asm volatile("" : "+v"(tid_));
    const int tid = tid_, wid = __builtin_amdgcn_readfirstlane(tid >> 6), lane = tid & 63, wr = wid >> 2, wc = wid & 3, fr = lane & 15, fq = lane >> 4;
    const int K = g.K, nt = K / BK;
    unsigned voffA[2], voffB[2];
#pragma unroll
    for (int i = 0; i < 2; ++i) { int R, C; stage_rc(tid * 16 + i * 8192, R, C); const int Rp = (R & ~31) + perm32(R & 31), Ra = SWAP ? Rp : R, Rb = (!SWAP && Epi::PERM) ? Rp : R;
        voffA[i] = (unsigned)(Ra * K + C) * 2u; voffB[i] = (unsigned)(Rb * K + C) * 2u; }
    const size_t kstep = (size_t)(BK * 2);
    const size_t hstep = (size_t)HALF * K * 2;
    const size_t tstep = 2 * hstep;
    const unsigned ldsw = (unsigned)wid * 1024u;
    const int aoff = lds_byte(wr * 64 + fr, fq * 8), boff = lds_byte(wc * 32 + fr, fq * 8);
#define PG8_SA(b, h) (((b) * 2 + (h)) * HTB)
#define PG8_SB(b, h) ((4 + (b) * 2 + (h)) * HTB)
#define PG8_STAGE(bufoff, gbase, voff) do { _Pragma("unroll") for (int _i = 0; _i < 2; ++_i) \
        __builtin_amdgcn_global_load_lds((const unsigned*)((const char*)(gbase) + (voff)[_i]), (PG8_LAS unsigned*)(lds + (bufoff) + ldsw + _i * 8192), 16, 0, 0); } while (0)
#define PG8_LD16(off) (*(const PG8_LAS i32x4*)(lds + (off)))
#define PG8_LDA(dst, b, h) do { _Pragma("unroll") for (int m = 0; m < 4; ++m) dst[m] = PG8_CAT8(PG8_LD16(PG8_SA(b, h) + aoff + m * 2048), PG8_LD16(PG8_SA(b, h) + aoff + m * 2048 + 1024)); } while (0)
#define PG8_LDB(dst, b, h) do { _Pragma("unroll") for (int n = 0; n < 2; ++n) dst[n] = PG8_CAT8(PG8_LD16(PG8_SB(b, h) + boff + n * 2048), PG8_LD16(PG8_SB(b, h) + boff + n * 2048 + 1024)); } while (0)
#define PG8_CAT8(x, y) __builtin_shufflevector((x), (y), 0, 1, 2, 3, 4, 5, 6, 7)
#define PG8_HALF(v, k) __builtin_bit_cast(bf16x8, __builtin_shufflevector((v), (v), 4 * (k), 4 * (k) + 1, 4 * (k) + 2, 4 * (k) + 3))
#define PG8_MMA(ai, bj, At, Bt) do { __builtin_amdgcn_s_setprio(1); _Pragma("unroll") for (int m = 0; m < 4; ++m) _Pragma("unroll") for (int n = 0; n < 2; ++n) { \
        if constexpr (F8 && SWAP) asm volatile("v_mfma_scale_f32_16x16x128_f8f6f4 %0, %1, %2, %0, %3, %3 op_sel_hi:[0,0,0]" : "+v"(acc[ai][bj][m][n]) : "v"(At[m]), "v"(Bt[n]), "v"(f8one)); \
        else if constexpr (F8) asm volatile("v_mfma_scale_f32_16x16x128_f8f6f4 %0, %1, %2, %0, %3, %3 op_sel_hi:[0,0,0]" : "+v"(acc[ai][bj][m][n]) : "v"(Bt[n]), "v"(At[m]), "v"(f8one));   \
        else if constexpr (SWAP) { acc[ai][bj][m][n] = __builtin_amdgcn_mfma_f32_16x16x32_bf16(PG8_HALF(At[m], 0), PG8_HALF(Bt[n], 0), acc[ai][bj][m][n], 0, 0, 0); \
               acc[ai][bj][m][n] = __builtin_amdgcn_mfma_f32_16x16x32_bf16(PG8_HALF(At[m], 1), PG8_HALF(Bt[n], 1), acc[ai][bj][m][n], 0, 0, 0); } \
        else { acc[ai][bj][m][n] = __builtin_amdgcn_mfma_f32_16x16x32_bf16(PG8_HALF(Bt[n], 0), PG8_HALF(At[m], 0), acc[ai][bj][m][n], 0, 0, 0); \
               acc[ai][bj][m][n] = __builtin_amdgcn_mfma_f32_16x16x32_bf16(PG8_HALF(Bt[n], 1), PG8_HALF(At[m], 1), acc[ai][bj][m][n], 0, 0, 0); } } \
        __builtin_amdgcn_s_setprio(0); } while (0)
#define PG8_WAIT_V(n) asm volatile("s_waitcnt vmcnt(" #n ")" ::: "memory")
#define PG8_WAIT_L(n) asm volatile("s_waitcnt lgkmcnt(" #n ")" ::: "memory")
#define PG8_BAR __builtin_amdgcn_s_barrier()
#define PG8_SCHED __builtin_amdgcn_sched_barrier(0)
    Unit cur, nxt; int ui = 0;
    if (!S.next(0, cur)) return;
    f32x4 acc[2][2][4][2];
#pragma unroll
    for (int a = 0; a < 2; ++a)
#pragma unroll
        for (int b = 0; b < 2; ++b)
#pragma unroll
            for (int m = 0; m < 4; ++m)
#pragma unroll
                for (int n = 0; n < 2; ++n) acc[a][b][m][n] = (f32x4){0.f, 0.f, 0.f, 0.f};
    const int f8one = 0x7f7f7f7f;
    i32x8 At[4], B0[2], B1[2];
    const char* cA = (const char*)g.A + (size_t)cur.pm * tstep; const char* cB = (const char*)g.Bt + (size_t)cur.pn * tstep;
    S.a_ready(cur);
    if constexpr (SP2) {
        PG8_STAGE(PG8_SB(0, 0), cB, voffB); PG8_STAGE(PG8_SB(0, 1), cB + hstep, voffB); PG8_STAGE(PG8_SA(0, 0), cA, voffA); PG8_STAGE(PG8_SA(0, 1), cA + hstep, voffA);
        if (wr == 1) PG8_BAR;
        PG8_WAIT_V(2); PG8_BAR;
        PG8_STAGE(PG8_SB(1, 0), cB + kstep, voffB); PG8_STAGE(PG8_SA(1, 0), cA + kstep, voffA); PG8_STAGE(PG8_SB(1, 1), cB + hstep + kstep, voffB);
        PG8_WAIT_V(6); PG8_BAR;
    } else {
        PG8_STAGE(PG8_SB(0, 0), cB, voffB); PG8_STAGE(PG8_SA(0, 0), cA, voffA); PG8_STAGE(PG8_SB(0, 1), cB + hstep, voffB); PG8_STAGE(PG8_SA(0, 1), cA + hstep, voffA);
        if (wr == 1) PG8_BAR;
        PG8_WAIT_V(4); PG8_BAR;
        PG8_STAGE(PG8_SB(1, 0), cB + kstep, voffB); PG8_STAGE(PG8_SA(1, 0), cA + kstep, voffA); PG8_STAGE(PG8_SB(1, 1), cB + hstep + kstep, voffB);
        PG8_WAIT_V(6); PG8_BAR;
    }
    for (;;) {
        const bool has_next = S.next(ui + 1, nxt);
        const char* nA = has_next ? (const char*)g.A + (size_t)nxt.pm * tstep : cA; const char* nB = has_next ? (const char*)g.Bt + (size_t)nxt.pn * tstep : cB;
        for (int t = 0; t < nt; t += 2) {
            const bool last = (t == nt - 2);
            const char* a1 = cA + (size_t)(t + 1) * kstep;
            const char* a2 = last ? nA : cA + (size_t)(t + 2) * kstep; const char* b2 = last ? nB : cB + (size_t)(t + 2) * kstep;
            const char* a3 = a2 + kstep; const char* b3 = b2 + kstep;
            if (last && has_next) S.a_ready(nxt);
            if constexpr (SP2) {
            PG8_LDB(B0, 0, 0); PG8_LDB(B1, 0, 1); PG8_SCHED; PG8_LDA(At, 0, 0); PG8_STAGE(PG8_SA(1, 1), a1 + hstep, voffA);
            PG8_WAIT_V(8); PG8_WAIT_L(0); PG8_BAR; PG8_MMA(0, 0, At, B0); PG8_MMA(0, 1, At, B1); PG8_BAR; PG8_SCHED;
            PG8_LDA(At, 0, 1); PG8_STAGE(PG8_SB(0, 0), b2, voffB); PG8_STAGE(PG8_SB(0, 1), b2 + hstep, voffB); PG8_STAGE(PG8_SA(0, 0), a2, voffA);
            PG8_WAIT_V(8); PG8_WAIT_L(0); PG8_BAR; PG8_MMA(1, 0, At, B0); PG8_MMA(1, 1, At, B1); PG8_BAR; PG8_SCHED;
            PG8_LDB(B0, 1, 0); PG8_LDB(B1, 1, 1); PG8_SCHED; PG8_LDA(At, 1, 0); PG8_STAGE(PG8_SA(0, 1), a2 + hstep, voffA);
            PG8_WAIT_V(8); PG8_WAIT_L(0); PG8_BAR; PG8_MMA(0, 0, At, B0); PG8_MMA(0, 1, At, B1); PG8_BAR; PG8_SCHED;
            PG8_LDA(At, 1, 1); PG8_STAGE(PG8_SB(1, 0), b3, voffB); PG8_STAGE(PG8_SB(1, 1), b3 + hstep, voffB); PG8_STAGE(PG8_SA(1, 0), a3, voffA);
            PG8_WAIT_V(8); PG8_WAIT_L(0); PG8_BAR; PG8_MMA(1, 0, At, B0); PG8_MMA(1, 1, At, B1); PG8_BAR; PG8_SCHED;
            } else {
            PG8_LDB(B0, 0, 0); PG8_SCHED; PG8_LDA(At, 0, 0); PG8_STAGE(PG8_SA(1, 1), a1 + hstep, voffA);
            PG8_WAIT_L(8); PG8_BAR; PG8_WAIT_L(0); PG8_MMA(0, 0, At, B0); PG8_BAR; PG8_SCHED;
            PG8_LDB(B1, 0, 1); PG8_STAGE(PG8_SB(0, 0), b2, voffB);
            PG8_BAR; PG8_WAIT_L(0); PG8_MMA(0, 1, At, B1); PG8_BAR;
            PG8_LDA(At, 0, 1); PG8_STAGE(PG8_SA(0, 0), a2, voffA);
            PG8_BAR; PG8_WAIT_L(0); PG8_MMA(1, 0, At, B0); PG8_BAR; PG8_SCHED;
            PG8_STAGE(PG8_SB(0, 1), b2 + hstep, voffB);
            PG8_WAIT_V(6); PG8_BAR; PG8_MMA(1, 1, At, B1); PG8_BAR;
            PG8_LDB(B0, 1, 0); PG8_SCHED; PG8_LDA(At, 1, 0); PG8_STAGE(PG8_SA(0, 1), a2 + hstep, voffA);
            PG8_WAIT_L(8); PG8_BAR; PG8_WAIT_L(0); PG8_MMA(0, 0, At, B0); PG8_BAR; PG8_SCHED;
            PG8_LDB(B1, 1, 1); PG8_STAGE(PG8_SB(1, 0), b3, voffB);
            PG8_BAR; PG8_WAIT_L(0); PG8_MMA(0, 1, At, B1); PG8_BAR;
            PG8_LDA(At, 1, 1); PG8_STAGE(PG8_SA(1, 0), a3, voffA);
            PG8_BAR; PG8_WAIT_L(0); PG8_MMA(1, 0, At, B0); PG8_BAR; PG8_SCHED;
            PG8_STAGE(PG8_SB(1, 1), b3 + hstep, voffB);
            PG8_WAIT_V(6); PG8_BAR; PG8_MMA(1, 1, At, B1); PG8_BAR;
            }
        }
        if constexpr (ALIGN_EPI) { if (wr == 0) PG8_BAR; }
        if constexpr (!Epi::AFTER_DRAIN) { E(acc, cur, wr, wc, fr, fq); S.done(cur); }
        if (!has_next) break;
#pragma unroll
        for (int a = 0; a < 2; ++a)
#pragma unroll
            for (int b = 0; b < 2; ++b)
#pragma unroll
                for (int m = 0; m < 4; ++m)
#pragma unroll
                    for (int n = 0; n < 2; ++n) acc[a][b][m][n] = (f32x4){0.f, 0.f, 0.f, 0.f};
        cur = nxt; cA = nA; cB = nB; ++ui;
        if constexpr (ALIGN_EPI) { if (wr == 1) PG8_BAR; }
    }
    PG8_WAIT_V(0);
    if constexpr (!ALIGN_EPI) { if (wr == 0) PG8_BAR; }
    PG8_BAR;
    if constexpr (Epi::AFTER_DRAIN) { E.fused(acc, cur, wr, wc, fr, fq, lds, wid, lane); S.done(cur); }
#undef PG8_SA
#undef PG8_SB
#undef PG8_STAGE
#undef PG8_LDA
#undef PG8_LDB
#undef PG8_MMA
#undef PG8_CAT8
#undef PG8_HALF
#undef PG8_LD16
#undef PG8_WAIT_V
#undef PG8_WAIT_L
#undef PG8_BAR
#undef PG8_SCHED
}
}

constexpr int NWAVES = 8, NTHREADS = NWAVES * 64;
constexpr int T = 32768, D = 1024, SEQ = 4096, NBATCH = 8;
constexpr int NQKV = 3072, DFF = 2816, DFFE = 3584, NEXP = 8, MLW = 3080;
constexpr float EPS = 1e-6f;
#ifndef LATE_QKV
#define LATE_QKV 1
#endif
#ifndef LATE_INP
#define LATE_INP 1
#endif
#ifndef LATE_OUT
#define LATE_OUT 0
#endif
#ifndef LATE_F8
#define LATE_F8 1
#endif
#ifndef DENSE_F8_L2
#define DENSE_F8_L2 1
#endif
constexpr float W_GU_SCALE = 64.f, W_D_SCALE = 128.f, X_SCALE = 4.f, ACT_SCALE = 4.f;
constexpr int NPH_PAIR = 18, NPHASES = 2 * NPH_PAIR + 1;
#ifndef MK_PER_PHASE
#define MK_PER_PHASE 0
#endif

constexpr size_t MiB = 1u << 20;
constexpr size_t WS_CTL = 0, CTL_ZERO_BYTES = MK_PER_PHASE ? 1 * MiB : 64 * 1024;
constexpr size_t WS_TOKE = 1 * MiB;
constexpr size_t WS_TOKW = WS_TOKE + 256 * 1024;
constexpr size_t WS_TOKP = WS_TOKW + 256 * 1024;
constexpr size_t WS_WGCNT = WS_TOKP + 256 * 1024;
constexpr size_t WS_EOFF = WS_WGCNT + 16 * 1024;
constexpr size_t WS_GATES = 2 * MiB;
constexpr size_t WS_TA = 3 * MiB, WS_TU = WS_TA + 512 * 1024, WS_TM = WS_TU + 512 * 1024, WS_CP = WS_TM + 512 * 1024, WS_CG = WS_CP + 64 * 1024;
constexpr size_t WS_W = 8 * MiB;
constexpr size_t WS_WQKV = WS_W, WS_WO = WS_W + 6 * MiB, WS_WGU = WS_W + 8 * MiB, WS_WD = WS_W + 19 * MiB;
constexpr size_t WS_WIN = WS_W, WS_WEGU = WS_W + 8 * MiB, WS_WED = WS_W + 64 * MiB;
constexpr size_t WS_XN = 184 * MiB;
constexpr size_t WS_R = 248 * MiB;
constexpr size_t WS_U = WS_R;
constexpr size_t WS_O = WS_R + 192 * MiB;
constexpr size_t WS_VTA = WS_R + 256 * MiB;
constexpr size_t WS_ACT = WS_R;
constexpr size_t WS_QF = WS_R + 192 * MiB, WS_KF = WS_R + 224 * MiB;
constexpr size_t WS_KT = WS_R + 256 * MiB;
constexpr size_t WS_VT = WS_R + 288 * MiB;
constexpr size_t WS_CTS = WS_R + 360 * MiB;
constexpr size_t WS_HM = WS_R + 504 * MiB;
constexpr size_t WS_XG = WS_R;
constexpr size_t WS_Y = WS_R + 66 * MiB;
constexpr size_t WS_ACTM = WS_R + 198 * MiB;
constexpr size_t WS_HB = 832 * MiB;
constexpr size_t WS_END = 896 * MiB;
constexpr int CW_BAR = 4096;

constexpr int RING_BYTES = 131072;
constexpr int LDSCTL_OFF = RING_BYTES;
constexpr int L_TEXP = LDSCTL_OFF;
constexpr int L_MISC = LDSCTL_OFF + 2048;
constexpr int L_CNT = LDSCTL_OFF + 2304;
constexpr int L_PTR = LDSCTL_OFF + 2560;
constexpr int L_SCR = LDSCTL_OFF + 4096;
constexpr int LDS_BYTES = 147456;

#define GAS __attribute__((address_space(1)))
#define LAS __attribute__((address_space(3)))
typedef unsigned short bf16;
typedef unsigned v4u __attribute__((ext_vector_type(4)));
typedef unsigned v2u __attribute__((ext_vector_type(2)));
typedef float f32x4 __attribute__((ext_vector_type(4)));
typedef GAS unsigned gu32;
#define RLX_AGENT __ATOMIC_RELAXED, __HIP_MEMORY_SCOPE_AGENT
#define LDS_WAIT() asm volatile("s_waitcnt lgkmcnt(0)" ::: "memory")
#define VM_WAIT() asm volatile("s_waitcnt vmcnt(0)" ::: "memory")
__device__ __forceinline__ unsigned f2bf(float f) { unsigned u = __builtin_bit_cast(unsigned, f); return (u + 0x7fffu + ((u >> 16) & 1u)) >> 16; }
__device__ __forceinline__ unsigned pk2(float lo, float hi) { return f2bf(lo) | (f2bf(hi) << 16); }
__device__ __forceinline__ float bflo(unsigned w) { return __builtin_bit_cast(float, w << 16); }
__device__ __forceinline__ float bfhi(unsigned w) { return __builtin_bit_cast(float, w & 0xffff0000u); }
__device__ __forceinline__ int ld_i32(const int* p) { return (int)__hip_atomic_load((const unsigned*)p, RLX_AGENT); }

#define XB_TMO      128
#define XB_XCNT(j)  (256  + 64 * (j))
#define XB_XSUB(j)  (1280 + 64 * (j))
#define XB_XGEN(j)  (2304 + 64 * (j))
#define XB_TOP      3328
#define XB_TOPGEN   3392
#define XCD_BAR_WORDS 3456
#define XB_SPIN_CAP (1u << 18)

__device__ __forceinline__ unsigned xb_ld(unsigned* p)              { return __hip_atomic_load(p, __ATOMIC_RELAXED, __HIP_MEMORY_SCOPE_AGENT); }
__device__ __forceinline__ unsigned xb_add(unsigned* p, unsigned v) { return __hip_atomic_fetch_add(p, v, __ATOMIC_RELAXED, __HIP_MEMORY_SCOPE_AGENT); }
__device__ __forceinline__ unsigned xb_xcc_id() { return (unsigned)__builtin_amdgcn_s_getreg((3 << 11) | 20) & 0xFu; }
#define XB_SPIN(cond, bar) do { unsigned _sp = 0; while (cond) { __builtin_amdgcn_s_sleep(1); \
    if ((++_sp & 255u) == 0u) { if (xb_ld(&(bar)[XB_TMO])) break; if (_sp > XB_SPIN_CAP) { atomicAdd(&(bar)[XB_TMO], 1u); break; } } } } while (0)

struct XcdBarrier {
    unsigned* bar; unsigned x;
    volatile LAS unsigned* st;
};

__device__ __forceinline__ XcdBarrier xcd_barrier_post(unsigned* bar, volatile LAS unsigned* st) {
    XcdBarrier b; b.bar = bar; b.x = xb_xcc_id(); b.st = st;
    if (threadIdx.x == 0) (void)xb_add(&bar[XB_XCNT(b.x)], 1u);
    return b;
}
__device__ __forceinline__ void xcd_barrier_complete(unsigned* bar, unsigned x, unsigned& nloc, unsigned& nx) {
    const unsigned G = gridDim.x * gridDim.y * gridDim.z;
    unsigned sum, cnt, mine, sp = 0u;
    for (;;) {
        sum = 0u; cnt = 0u; mine = 0u;
#pragma unroll
        for (unsigned j = 0; j < 16; ++j) { const unsigned c = xb_ld(&bar[XB_XCNT(j)]); sum += c; cnt += (c > 0u) ? 1u : 0u; mine = (j == x) ? c : mine; }
        if (sum == G) break;
        __builtin_amdgcn_s_sleep(1);
        if ((++sp & 255u) == 0u) { if (xb_ld(&bar[XB_TMO])) break; if (sp > XB_SPIN_CAP) { atomicAdd(&bar[XB_TMO], 1u); break; } }
    }
    nloc = mine > 0u ? mine : 1u; nx = cnt > 0u ? cnt : 1u;
}

__device__ __forceinline__ void xcd_barrier(const XcdBarrier& b) {
    asm volatile("s_waitcnt vmcnt(0)" ::: "memory");
    __syncthreads();
    if (threadIdx.x == 0) {
        unsigned* bar = b.bar;
        __builtin_amdgcn_s_waitcnt(0);
        unsigned nloc = b.st[0], nx = b.st[1];
        if (nloc == 0u) { xcd_barrier_complete(bar, b.x, nloc, nx); b.st[0] = nloc; b.st[1] = nx; }
        const unsigned old = xb_add(&bar[XB_XSUB(b.x)], 1u);
        const unsigned gen = old / nloc;
        if (old + 1u == (gen + 1u) * nloc) {
            __builtin_amdgcn_fence(__ATOMIC_RELEASE, "agent");
            asm volatile("s_waitcnt vmcnt(0)" ::: "memory");
            const unsigned og = xb_add(&bar[XB_TOP], 1u);
            const unsigned tg = og / nx;
            if (og + 1u == (tg + 1u) * nx) xb_add(&bar[XB_TOPGEN], 1u);
            else XB_SPIN(xb_ld(&bar[XB_TOPGEN]) == tg, bar);
            __builtin_amdgcn_fence(__ATOMIC_ACQUIRE, "agent");
            xb_add(&bar[XB_XGEN(b.x)], 1u);
            asm volatile("s_waitcnt vmcnt(0)" ::: "memory");
        } else {
            XB_SPIN(xb_ld(&bar[XB_XGEN(b.x)]) == gen, bar);
            __builtin_amdgcn_fence(__ATOMIC_ACQUIRE, "agent");
            asm volatile("s_waitcnt vmcnt(0)" ::: "memory");
        }
    }
    __syncthreads();
}
struct Frame {
    LAS unsigned char* lds;
    volatile LAS unsigned* MISC;
    int tid, lane, wave, wg, G, vwg;
    unsigned char* ws;
};
__device__ __forceinline__ void* ldptr(Frame& F, int i) {
    const unsigned long long v = ((const LAS unsigned long long*)(F.lds + L_PTR))[i];
    const unsigned lo = __builtin_amdgcn_readfirstlane((unsigned)v), hi = __builtin_amdgcn_readfirstlane((unsigned)(v >> 32));
    return (void*)(((unsigned long long)hi << 32) | lo);
}
__device__ __forceinline__ float shfl_idx_l(float v, int src) { return __builtin_bit_cast(float, __builtin_amdgcn_ds_bpermute(src << 2, __builtin_bit_cast(int, v))); }
__device__ __forceinline__ float shfl_xor_l(float v, int o, int lane) { return shfl_idx_l(v, lane ^ o); }
__device__ __forceinline__ float xh_sum(float v) { const int x = __builtin_bit_cast(int, v); const auto r = __builtin_amdgcn_permlane32_swap(x, x, false, false); return __builtin_bit_cast(float, (int)r[0]) + __builtin_bit_cast(float, (int)r[1]); }
__device__ __forceinline__ float xh_max(float v) { const int x = __builtin_bit_cast(int, v); const auto r = __builtin_amdgcn_permlane32_swap(x, x, false, false); return fmaxf(__builtin_bit_cast(float, (int)r[0]), __builtin_bit_cast(float, (int)r[1])); }
__device__ __forceinline__ float xh_other(float v, int hi) { const int x = __builtin_bit_cast(int, v); const auto r = __builtin_amdgcn_permlane32_swap(x, x, false, false); return hi ? __builtin_bit_cast(float, (int)r[0]) : __builtin_bit_cast(float, (int)r[1]); }
__device__ __forceinline__ float wave_sum(float v, int lane) {
    (void)lane;
    int x = __builtin_bit_cast(int, v);
    v += __builtin_bit_cast(float, __builtin_amdgcn_update_dpp(0, x, 0xB1, 0xF, 0xF, true)); x = __builtin_bit_cast(int, v);
    v += __builtin_bit_cast(float, __builtin_amdgcn_update_dpp(0, x, 0x4E, 0xF, 0xF, true)); x = __builtin_bit_cast(int, v);
    v += __builtin_bit_cast(float, __builtin_amdgcn_update_dpp(0, x, 0x124, 0xF, 0xF, true)); x = __builtin_bit_cast(int, v);
    v += __builtin_bit_cast(float, __builtin_amdgcn_update_dpp(0, x, 0x128, 0xF, 0xF, true)); x = __builtin_bit_cast(int, v);
    const float r0 = __builtin_bit_cast(float, __builtin_amdgcn_readlane(x, 0)), r1 = __builtin_bit_cast(float, __builtin_amdgcn_readlane(x, 16));
    const float r2 = __builtin_bit_cast(float, __builtin_amdgcn_readlane(x, 32)), r3 = __builtin_bit_cast(float, __builtin_amdgcn_readlane(x, 48));
    return (r0 + r1) + (r2 + r3);
}

__device__ __forceinline__ void tr_item(const float* W, int ldw, int K, int nblk, int item, bf16* WT, int mode, int half, LAS float* scr, int lane) {
    const int kb = item / nblk, nb = item - kb * nblk, k0 = 64 * kb, n0 = 32 * nb;
    const int drow0 = mode == 0 ? n0 : ((n0 >> 7) * 256 + half * 128 + (n0 & 127));
    float wv[32];
    const GAS float* wsrc = (const GAS float*)W + (size_t)(k0 + (lane >> 5)) * ldw + n0 + (lane & 31);
#pragma unroll
    for (int i = 0; i < 32; ++i) wv[i] = __builtin_nontemporal_load(wsrc + (size_t)(2 * i) * ldw);
#pragma unroll
    for (int i = 0; i < 32; ++i) scr[(2 * i + (lane >> 5)) * 33 + (lane & 31)] = wv[i];
    LDS_WAIT(); asm volatile("" ::: "memory");
    const int c = lane & 7;
#pragma unroll
    for (int j = 0; j < 4; ++j) { const int n = (lane >> 3) + 8 * j; const LAS float* s = scr + (8 * c) * 33 + n;
        v4u o; o.x = pk2(s[0 * 33], s[1 * 33]); o.y = pk2(s[2 * 33], s[3 * 33]); o.z = pk2(s[4 * 33], s[5 * 33]); o.w = pk2(s[6 * 33], s[7 * 33]);
        *(GAS v4u*)(WT + (size_t)(drow0 + n) * K + k0 + 8 * c) = o; }
    LDS_WAIT(); asm volatile("" ::: "memory");
}
__device__ __forceinline__ void tr_item_f8(const float* W, int ldw, int K, int nblk, int item, unsigned char* WT, int mode, int half, float scale, LAS float* scr, int lane) {
    const int kb = item / nblk, nb = item - kb * nblk, k0 = 128 * kb, n0 = 32 * nb;
    const int drow0 = mode == 0 ? n0 : ((n0 >> 7) * 256 + half * 128 + (n0 & 127));
    float wv[64];
    const GAS float* wsrc = (const GAS float*)W + (size_t)(k0 + (lane >> 5)) * ldw + n0 + (lane & 31);
#pragma unroll
    for (int i = 0; i < 64; ++i) wv[i] = __builtin_nontemporal_load(wsrc + (size_t)(2 * i) * ldw);
#pragma unroll
    for (int i = 0; i < 64; ++i) scr[(2 * i + (lane >> 5)) * 32 + (((lane & 31) + 4 * (i >> 3)) & 31)] = wv[i];
    LDS_WAIT(); asm volatile("" ::: "memory");
    const int c = lane & 7;
#pragma unroll
    for (int j = 0; j < 4; ++j) { const int n = (lane >> 3) + 8 * j; const LAS float* s = scr + (16 * c) * 32 + ((n + 4 * c) & 31);
        v4u o; o.x = pg8::pk4_f8(s[0 * 32] * scale, s[1 * 32] * scale, s[2 * 32] * scale, s[3 * 32] * scale); o.y = pg8::pk4_f8(s[4 * 32] * scale, s[5 * 32] * scale, s[6 * 32] * scale, s[7 * 32] * scale);
        o.z = pg8::pk4_f8(s[8 * 32] * scale, s[9 * 32] * scale, s[10 * 32] * scale, s[11 * 32] * scale); o.w = pg8::pk4_f8(s[12 * 32] * scale, s[13 * 32] * scale, s[14 * 32] * scale, s[15 * 32] * scale);
        *(GAS v4u*)(WT + (size_t)(drow0 + n) * K + k0 + 16 * c) = o; }
    LDS_WAIT(); asm volatile("" ::: "memory");
}
template <bool F8D, bool L8, bool L8O> __device__ __forceinline__ void convert_even(Frame& F, const float* w_in, const float* w_out, const float* w_g, const float* w_u, const float* w_d, int wg0 = 0) {
    if (F.wg < wg0) return;
    LAS float* scr = (LAS float*)(F.lds + F.wave * 16384);
    const int gw = (F.wg - wg0) * NWAVES + F.wave, NGW = (F.G - wg0) * NWAVES;
    constexpr int I0 = (L8 ? 8 : 16) * 96, I1 = (L8O ? 8 : 16) * 32, I2 = (F8D ? 8 : 16) * 88, I4 = (F8D ? 22 : 44) * 32;
    bf16* Wqkv = (bf16*)(F.ws + WS_WQKV); bf16* Wo = (bf16*)(F.ws + WS_WO); bf16* Wgu = (bf16*)(F.ws + WS_WGU); bf16* Wd = (bf16*)(F.ws + WS_WD);
    for (int it = gw; it < I0 + I1 + 2 * I2 + I4; it += NGW) {
        int r = it;
        if (r < I0) { if (L8) tr_item_f8(w_in, NQKV, D, 96, r, (unsigned char*)Wqkv, 0, 0, W_GU_SCALE, scr, F.lane); else tr_item(w_in, NQKV, D, 96, r, Wqkv, 0, 0, scr, F.lane); continue; } r -= I0;
        if (r < I1) { if (L8O) tr_item_f8(w_out, D, D, 32, r, (unsigned char*)Wo, 0, 0, W_GU_SCALE, scr, F.lane); else tr_item(w_out, D, D, 32, r, Wo, 0, 0, scr, F.lane); continue; } r -= I1;
        if (F8D) {
            if (r < I2) { tr_item_f8(w_g, DFF, D, 88, r, (unsigned char*)Wgu, 1, 0, W_GU_SCALE, scr, F.lane); continue; } r -= I2;
            if (r < I2) { tr_item_f8(w_u, DFF, D, 88, r, (unsigned char*)Wgu, 1, 1, W_GU_SCALE, scr, F.lane); continue; } r -= I2;
            tr_item_f8(w_d, D, DFF, 32, r, (unsigned char*)Wd, 0, 0, W_D_SCALE, scr, F.lane);
        } else {
            if (r < I2) { tr_item(w_g, DFF, D, 88, r, Wgu, 1, 0, scr, F.lane); continue; } r -= I2;
            if (r < I2) { tr_item(w_u, DFF, D, 88, r, Wgu, 1, 1, scr, F.lane); continue; } r -= I2;
            tr_item(w_d, D, DFF, 32, r, Wd, 0, 0, scr, F.lane);
        }
    }
}
template <bool L8, bool L8O> __device__ __forceinline__ void convert_odd(Frame& F, const float* w_in, const float* w_out, const float* w_g, const float* w_u, const float* w_d) {
    LAS float* scr = (LAS float*)(F.lds + F.wave * 16384);
    const int gw = F.wg * NWAVES + F.wave, NGW = F.G * NWAVES;
    constexpr int I0 = (L8 ? 8 : 16) * 96, I1 = (L8O ? 8 : 16) * 32, IE = 8 * 112, ID = 28 * 32;
    bf16* Win = (bf16*)(F.ws + WS_WIN); bf16* Wo = (bf16*)(F.ws + WS_WO); unsigned char* Wegu = F.ws + WS_WEGU; unsigned char* Wed = F.ws + WS_WED;
    for (int it = gw; it < I0 + I1 + NEXP * (2 * IE + ID); it += NGW) {
        int r = it;
        if (r < I0) { if (L8) tr_item_f8(w_in, MLW, D, 96, r, (unsigned char*)Win, 0, 0, W_GU_SCALE, scr, F.lane); else tr_item(w_in, MLW, D, 96, r, Win, 0, 0, scr, F.lane); continue; } r -= I0;
        if (r < I1) { if (L8O) tr_item_f8(w_out, D, D, 32, r, (unsigned char*)Wo, 0, 0, W_GU_SCALE, scr, F.lane); else tr_item(w_out, D, D, 32, r, Wo, 0, 0, scr, F.lane); continue; } r -= I1;
        if (r < NEXP * IE) { const int e = r / IE; tr_item_f8(w_g + (size_t)e * D * DFFE, DFFE, D, 112, r - e * IE, Wegu + (size_t)e * 2 * DFFE * D, 1, 0, W_GU_SCALE, scr, F.lane); continue; } r -= NEXP * IE;
        if (r < NEXP * IE) { const int e = r / IE; tr_item_f8(w_u + (size_t)e * D * DFFE, DFFE, D, 112, r - e * IE, Wegu + (size_t)e * 2 * DFFE * D, 1, 1, W_GU_SCALE, scr, F.lane); continue; } r -= NEXP * IE;
        { const int e = r / ID; tr_item_f8(w_d + (size_t)e * DFFE * D, D, DFFE, 32, r - e * ID, Wed + (size_t)e * D * DFFE, 0, 0, W_D_SCALE, scr, F.lane); }
    }
}

template <bool COMBINE, int EXTRA, bool XF8 = false, bool HF32 = false>
__device__ __forceinline__ void norm_phase(Frame& F, const void* hin, bf16* hout, const float* gain, bf16* xn, float* fout,
                                           const float* wsmall  , const float* b_i, const float* b_f) {
    LAS float* WL = (LAS float*)F.lds;
    LAS int* cnt = (LAS int*)(F.lds + L_CNT);
    if (EXTRA == 1) { for (int idx = F.tid; idx < 8 * D; idx += NTHREADS) { const int k = idx >> 3, e = idx & 7; WL[e * D + k] = wsmall[(size_t)k * MLW + NQKV + e]; } }
    if (EXTRA == 2) { for (int idx = F.tid; idx < 8 * D; idx += NTHREADS) { const int k = idx >> 3, e = idx & 7; WL[e * D + k] = wsmall[idx]; }
                      if (F.tid < 8) cnt[F.tid] = 0; }
    if (EXTRA == 1 || EXTRA == 2) __syncthreads();
    const int* tokp = (const int*)(F.ws + WS_TOKP); const float* tokw = (const float*)(F.ws + WS_TOKW); const bf16* Y = (const bf16*)(F.ws + WS_Y);
    f32x4 g[4];
#pragma unroll
    for (int j = 0; j < 4; ++j) g[j] = ((const GAS f32x4*)gain)[F.lane + 64 * j];
    const int row0 = F.wg * 128 + F.wave * 16;
    for (int i0 = 0; i0 < 16; i0 += 2) {
        f32x4 hf[2][4]; v2u hr[2][4], ya[2][4], yb[2][4]; int p0_[2], p1_[2]; float w0_[2], w1_[2];
#pragma unroll
        for (int u = 0; u < 2; ++u) { const int row = row0 + i0 + u;
            if (COMBINE) { p0_[u] = tokp[2 * row]; p1_[u] = tokp[2 * row + 1]; w0_[u] = tokw[2 * row]; w1_[u] = tokw[2 * row + 1]; }
#pragma unroll
            for (int j = 0; j < 4; ++j) { if (HF32) hf[u][j] = ((const GAS f32x4*)((const float*)hin + (size_t)row * D))[F.lane + 64 * j]; else hr[u][j] = ((const GAS v2u*)((const bf16*)hin + (size_t)row * D))[F.lane + 64 * j]; } }
        if (COMBINE) {
#pragma unroll
            for (int u = 0; u < 2; ++u)
#pragma unroll
                for (int j = 0; j < 4; ++j) { ya[u][j] = __builtin_nontemporal_load((const GAS v2u*)(Y + (size_t)p0_[u] * D) + F.lane + 64 * j); yb[u][j] = __builtin_nontemporal_load((const GAS v2u*)(Y + (size_t)p1_[u] * D) + F.lane + 64 * j); } }
#pragma unroll
      for (int u = 0; u < 2; ++u) {
        const int i = i0 + u, row = row0 + i;
        f32x4 v[4];
#pragma unroll
        for (int j = 0; j < 4; ++j) { if (HF32) v[j] = hf[u][j]; else { const v2u t = hr[u][j]; v[j] = (f32x4){bflo(t.x), bfhi(t.x), bflo(t.y), bfhi(t.y)}; } }
        if (COMBINE) {
            const float w0 = w0_[u], w1 = w1_[u];
#pragma unroll
            for (int j = 0; j < 4; ++j) { const v2u a = ya[u][j], b = yb[u][j];
                v[j].x += w0 * bflo(a.x) + w1 * bflo(b.x); v[j].y += w0 * bfhi(a.x) + w1 * bfhi(b.x); v[j].z += w0 * bflo(a.y) + w1 * bflo(b.y); v[j].w += w0 * bfhi(a.y) + w1 * bfhi(b.y); }
            if (EXTRA != 3) {
#pragma unroll
                for (int j = 0; j < 4; ++j) { v2u o; o.x = pk2(v[j].x, v[j].y); o.y = pk2(v[j].z, v[j].w); ((GAS v2u*)(hout + (size_t)row * D))[F.lane + 64 * j] = o; } }
        }
        float ss = 0.f;
#pragma unroll
        for (int j = 0; j < 4; ++j) ss += (v[j].x * v[j].x + v[j].y * v[j].y) + (v[j].z * v[j].z + v[j].w * v[j].w);
        const float rstd = 1.0f / sqrtf(wave_sum(ss, F.lane) * (1.0f / D) + EPS);
#pragma unroll
        for (int j = 0; j < 4; ++j) v[j] = v[j] * rstd * g[j];
        if (EXTRA == 3) {
#pragma unroll
            for (int j = 0; j < 4; ++j) __builtin_nontemporal_store(v[j], (GAS f32x4*)(fout + (size_t)row * D) + F.lane + 64 * j);
        } else if (EXTRA == 4 || XF8) {
#pragma unroll
            for (int j = 0; j < 4; ++j) ((GAS unsigned*)((unsigned char*)xn + (size_t)row * D))[F.lane + 64 * j] = pg8::pk4_f8(v[j].x * X_SCALE, v[j].y * X_SCALE, v[j].z * X_SCALE, v[j].w * X_SCALE);
        } else {
#pragma unroll
            for (int j = 0; j < 4; ++j) { v2u o; o.x = pk2(v[j].x, v[j].y); o.y = pk2(v[j].z, v[j].w); ((GAS v2u*)(xn + (size_t)row * D))[F.lane + 64 * j] = o; }
        }
        if (EXTRA == 1 || EXTRA == 2) {
            float lg[8];
#pragma unroll
            for (int e = 0; e < 8; ++e) { float p = 0.f;
#pragma unroll
                for (int j = 0; j < 4; ++j) { const f32x4 w = *(const LAS f32x4*)(WL + e * D + 256 * j + 4 * F.lane); p += (v[j].x * w.x + v[j].y * w.y) + (v[j].z * w.z + v[j].w * w.w); }
                lg[e] = wave_sum(p, F.lane); }
            if (EXTRA == 1) {
                float* gates = (float*)(F.ws + WS_GATES);
                float val = 0.f;
#pragma unroll
                for (int e = 0; e < 8; ++e) if (F.lane == e) val = lg[e];
                if (F.lane < 4) { const float ip = 15.0f * tanhf((val + b_i[F.lane]) * (1.0f / 15.0f)); gates[(size_t)row * 8 + F.lane] = ip; }
                else if (F.lane < 8) { const float fp = 15.0f * tanhf((val + b_f[F.lane - 4]) * (1.0f / 15.0f)); gates[(size_t)row * 8 + F.lane] = fminf(fp, 0.f) - log1pf(__expf(-fabsf(fp))); }
            } else {
                int e0 = 0; float v0 = lg[0];
#pragma unroll
                for (int e = 1; e < 8; ++e) if (lg[e] > v0) { v0 = lg[e]; e0 = e; }
                int e1 = -1; float v1 = -INFINITY;
#pragma unroll
                for (int e = 0; e < 8; ++e) if (e != e0 && lg[e] > v1) { v1 = lg[e]; e1 = e; }
                const float ex = __expf(v1 - v0), w0 = 1.0f / (1.0f + ex), w1 = ex * w0;
                if (F.lane == 0) {
                    ((int*)(F.ws + WS_TOKE))[row] = e0 | (e1 << 8);
                    ((float*)(F.ws + WS_TOKW))[2 * row] = w0; ((float*)(F.ws + WS_TOKW))[2 * row + 1] = w1;
                    __hip_atomic_fetch_add(cnt + e0, 1, __ATOMIC_RELAXED, __HIP_MEMORY_SCOPE_WORKGROUP);
                    __hip_atomic_fetch_add(cnt + e1, 1, __ATOMIC_RELAXED, __HIP_MEMORY_SCOPE_WORKGROUP);
                }
            }
        }
    }
    }
    if (EXTRA == 2) { __syncthreads(); if (F.tid < 8) ((int*)(F.ws + WS_WGCNT))[F.wg * 8 + F.tid] = cnt[F.tid]; }
    if (EXTRA == 1 || EXTRA == 2) __syncthreads();
}

__device__ __forceinline__ void moe_assign_gather(Frame& F) {
    LAS int* S = (LAS int*)(F.lds + L_SCR);
    LAS int* tot = S; LAS int* pre = S + 8; LAS int* eo = S + 16  ; LAS int* base = S + 32; LAS int* te = S + 64  ; LAS int* lpos = S + 192  ;
    LAS int* big = (LAS int*)F.lds;
    const int* wgcnt = (const int*)(F.ws + WS_WGCNT);
    for (int i = F.tid; i < F.G * 8; i += NTHREADS) big[i] = ld_i32(wgcnt + i);
    if (F.tid < 128) te[F.tid] = ld_i32((const int*)(F.ws + WS_TOKE) + F.wg * 128 + F.tid);
    __syncthreads();
    { const int e = F.wave;
      int c4[4], sl = 0;
#pragma unroll
      for (int k = 0; k < 4; ++k) { c4[k] = big[(4 * F.lane + k) * 8 + e]; sl += c4[k]; }
      int inc = sl;
#pragma unroll
      for (int o = 1; o < 64; o <<= 1) { const int y = __builtin_amdgcn_ds_bpermute(((F.lane - o) & 63) << 2, inc); if (F.lane >= o) inc += y; }
      const int wq = F.wg >> 2, wr4 = F.wg & 3;
      int mine = inc - sl;
#pragma unroll
      for (int k = 0; k < 3; ++k) if (k < wr4) mine += c4[k];
      const int p = __builtin_amdgcn_ds_bpermute(wq << 2, mine), t = __builtin_amdgcn_ds_bpermute(63 << 2, inc);
      if (F.lane == 0) { tot[e] = t; pre[e] = p; } }
    __syncthreads();
    if (F.tid == 0) { int o = 0; for (int e = 0; e < 8; ++e) { eo[e] = o; base[e] = o + pre[e]; o += (tot[e] + 255) & ~255; } eo[8] = o;
        if (F.wg == 0) { int* g = (int*)(F.ws + WS_EOFF); for (int e = 0; e < 9; ++e) g[e] = eo[e]; g[9] = o >> 8; } }
    __syncthreads();
    { const int e = F.wave;
      const int w0 = te[2 * F.lane], w1 = te[2 * F.lane + 1];
      const int m0 = (w0 & 255) == e, m1 = (w0 >> 8) == e, m2 = (w1 & 255) == e, m3 = (w1 >> 8) == e, cl = m0 + m1 + m2 + m3;
      int inc = cl;
#pragma unroll
      for (int o = 1; o < 64; o <<= 1) { const int y = __builtin_amdgcn_ds_bpermute(((F.lane - o) & 63) << 2, inc); if (F.lane >= o) inc += y; }
      int b = base[e] + inc - cl;
      if (m0) lpos[4 * F.lane] = b++; if (m1) lpos[4 * F.lane + 1] = b++; if (m2) lpos[4 * F.lane + 2] = b++; if (m3) lpos[4 * F.lane + 3] = b++; }
    __syncthreads();
    if (F.tid < 256) ((int*)(F.ws + WS_TOKP))[F.wg * 256 + F.tid] = lpos[F.tid];
    const unsigned char* XN8 = F.ws + WS_XN; unsigned char* XG = F.ws + WS_XG;
    { v4u rr[16];
#pragma unroll
      for (int k = 0; k < 16; ++k) rr[k] = __builtin_nontemporal_load((const GAS v4u*)(XN8 + (size_t)(F.wg * 128 + F.wave * 16 + k) * D) + F.lane);
#pragma unroll
      for (int k = 0; k < 16; ++k) { const int lt = F.wave * 16 + k;
#pragma unroll
        for (int s2 = 0; s2 < 2; ++s2) { const int pos = lpos[2 * lt + s2]; ((GAS v4u*)(XG + (size_t)pos * D))[F.lane] = rr[k]; } } }
    if (F.wg < 8) { const int r0 = eo[F.wg] + tot[F.wg], r1 = eo[F.wg + 1]; const v4u z = (v4u){0u, 0u, 0u, 0u};
        for (int r = r0 + F.wave; r < r1; r += NWAVES) ((GAS v4u*)(XG + (size_t)r * D))[F.lane] = z; }
    __syncthreads();
}
__device__ __forceinline__ int moe_tile_table(Frame& F) {
    LAS int* eo = (LAS int*)(F.lds + L_SCR); LAS int* texp = (LAS int*)(F.lds + L_TEXP);
    __syncthreads();
    if (F.tid < 10) eo[F.tid] = ld_i32((const int*)(F.ws + WS_EOFF) + F.tid);
    __syncthreads();
    const int nt = eo[9];
    for (int t = F.tid; t < nt; t += NTHREADS) { int e = 0;
#pragma unroll
        for (int j = 1; j < 8; ++j) e += (eo[j] <= 256 * t) ? 1 : 0;
        texp[t] = e; }
    __syncthreads();
    return nt;
}

typedef short bf16x8_t __attribute__((ext_vector_type(8)));
typedef float f32x16 __attribute__((ext_vector_type(16)));
#define MFMA32(a, b, c) __builtin_amdgcn_mfma_f32_32x32x16_bf16((a), (b), (c), 0, 0, 0)
__device__ __forceinline__ unsigned cvtpk(float lo, float hi) { typedef float f2 __attribute__((ext_vector_type(2))); typedef __bf16 b2 __attribute__((ext_vector_type(2))); f2 v = {lo, hi}; b2 b = __builtin_convertvector(v, b2); return __builtin_bit_cast(unsigned, b); }
__device__ __forceinline__ bf16x8_t mk_frag(unsigned a, unsigned b, unsigned c, unsigned d) { v4u w = {a, b, c, d}; return __builtin_bit_cast(bf16x8_t, w); }
constexpr int NRT = T / 32;
__device__ __forceinline__ const bf16* uf_block(const bf16* UF, int colblock, int rowtile) { return UF + ((size_t)colblock * NRT + rowtile) * 512; }
__device__ __forceinline__ const bf16* uf_piece(const bf16* UF, int row, int c0) { return UF + ((size_t)(c0 >> 4) * NRT + (row >> 5)) * 512 + ((row & 31) + 32 * ((c0 >> 3) & 1)) * 8; }

__device__ __forceinline__ void mlstm_scalars(Frame& F) {
    const float* gates = (const float*)(F.ws + WS_GATES); float* TA = (float*)(F.ws + WS_TA); float* TB = (float*)(F.ws + WS_TU); float* TP = (float*)(F.ws + WS_TM); float* CG = (float*)(F.ws + WS_CG);
    for (int task = F.wg * NWAVES + F.wave; task < 2048; task += F.G * NWAVES) {
        const int bh = task >> 6, c = task & 63, b = bh >> 2, hh = bh & 3;
        const size_t tok = (size_t)b * SEQ + 64 * c + F.lane;
        const float li = gates[tok * 8 + hh], lf = gates[tok * 8 + 4 + hh];
        float bc = lf;
#pragma unroll
        for (int o = 1; o < 64; o <<= 1) { const float y = shfl_idx_l(bc, (F.lane - o) & 63); if (F.lane >= o) bc += y; }
        const float a = li - bc; float pm = a;
#pragma unroll
        for (int o = 1; o < 64; o <<= 1) { const float y = shfl_idx_l(pm, (F.lane - o) & 63); if (F.lane >= o) pm = fmaxf(pm, y); }
        const int ti = bh * SEQ + 64 * c + F.lane;
        TA[ti] = a; TB[ti] = bc; TP[ti] = pm;
        if (F.lane == 63) { CG[(bh * 64 + c) * 2] = bc; CG[(bh * 64 + c) * 2 + 1] = pm; }
    }
}
__device__ __forceinline__ void conv8(const bf16* UF, const float* cw, const float* cb, int row, int s, int c0, float sc, float (&a)[8]) {
    { const f32x4 b0 = *(const GAS f32x4*)(cb + c0), b1 = *(const GAS f32x4*)(cb + c0 + 4); a[0] = b0.x; a[1] = b0.y; a[2] = b0.z; a[3] = b0.w; a[4] = b1.x; a[5] = b1.y; a[6] = b1.z; a[7] = b1.w; }
#pragma unroll
    for (int j = 0; j < 4; ++j) {
        if (s - 3 + j >= 0) {
            const v4u x = *(const GAS v4u*)uf_piece(UF, row - 3 + j, c0);
            const f32x4 w0 = *(const GAS f32x4*)(cw + j * 1024 + c0), w1 = *(const GAS f32x4*)(cw + j * 1024 + c0 + 4);
            a[0] += w0.x * bflo(x.x); a[1] += w0.y * bfhi(x.x); a[2] += w0.z * bflo(x.y); a[3] += w0.w * bfhi(x.y);
            a[4] += w1.x * bflo(x.z); a[5] += w1.y * bfhi(x.z); a[6] += w1.z * bflo(x.w); a[7] += w1.w * bfhi(x.w);
        }
    }
#pragma unroll
    for (int e = 0; e < 8; ++e) a[e] = a[e] * __builtin_amdgcn_rcpf(1.0f + __expf(-a[e])) * sc;
}
__device__ __forceinline__ void mlstm_qconv(Frame& F, const float* cw, const float* cb, int wg0) {
    const bf16* UF = (const bf16*)(F.ws + WS_U); bf16* QF = (bf16*)(F.ws + WS_QF);
    const int nw = (F.G - wg0) * NWAVES, w = (F.wg - wg0) * NWAVES + F.wave;
    const int cbk = w & 31, c0 = 16 * cbk + 8 * (F.lane >> 5), rstep = nw >> 5;
    float wt[4][8], bs[8];
    { const f32x4 b0 = *(const GAS f32x4*)(cb + c0), b1 = *(const GAS f32x4*)(cb + c0 + 4); bs[0] = b0.x; bs[1] = b0.y; bs[2] = b0.z; bs[3] = b0.w; bs[4] = b1.x; bs[5] = b1.y; bs[6] = b1.z; bs[7] = b1.w; }
#pragma unroll
    for (int j = 0; j < 4; ++j) { const f32x4 w0 = *(const GAS f32x4*)(cw + j * 1024 + c0), w1 = *(const GAS f32x4*)(cw + j * 1024 + c0 + 4);
        wt[j][0] = w0.x; wt[j][1] = w0.y; wt[j][2] = w0.z; wt[j][3] = w0.w; wt[j][4] = w1.x; wt[j][5] = w1.y; wt[j][6] = w1.z; wt[j][7] = w1.w; }
    constexpr int U = 4;
    for (int rt0 = w >> 5; rt0 < NRT; rt0 += U * rstep) {
        v4u x[U][4];
#pragma unroll
        for (int u = 0; u < U; ++u) { const int rt = rt0 + u * rstep, row = 32 * rt + (F.lane & 31), sq = row & (SEQ - 1);
#pragma unroll
            for (int j = 0; j < 4; ++j) { x[u][j] = (v4u){0u, 0u, 0u, 0u}; if (rt < NRT && sq - 3 + j >= 0) x[u][j] = *(const GAS v4u*)uf_piece(UF, row - 3 + j, c0); } }
#pragma unroll
        for (int u = 0; u < U; ++u) { const int rt = rt0 + u * rstep; if (rt >= NRT) break;
            float a[8];
#pragma unroll
            for (int e = 0; e < 8; ++e) a[e] = bs[e];
#pragma unroll
            for (int j = 0; j < 4; ++j) { const v4u xx = x[u][j];
                a[0] += wt[j][0] * bflo(xx.x); a[1] += wt[j][1] * bfhi(xx.x); a[2] += wt[j][2] * bflo(xx.y); a[3] += wt[j][3] * bfhi(xx.y);
                a[4] += wt[j][4] * bflo(xx.z); a[5] += wt[j][5] * bfhi(xx.z); a[6] += wt[j][6] * bflo(xx.w); a[7] += wt[j][7] * bfhi(xx.w); }
#pragma unroll
            for (int e = 0; e < 8; ++e) a[e] = a[e] * __builtin_amdgcn_rcpf(1.0f + __expf(-a[e]));
            v4u o; o.x = pk2(a[0], a[1]); o.y = pk2(a[2], a[3]); o.z = pk2(a[4], a[5]); o.w = pk2(a[6], a[7]);
            *(GAS v4u*)(QF + (((size_t)cbk * NRT + rt) * 64 + F.lane) * 8) = o; }
    }
}
__device__ __forceinline__ void mlstm_prep(Frame& F, const float* cw, const float* cb) {
    const bf16* UF = (const bf16*)(F.ws + WS_U); bf16* QF = (bf16*)(F.ws + WS_QF); bf16* KF = (bf16*)(F.ws + WS_KF); bf16* KWF = (bf16*)(F.ws + WS_KT); bf16* VF = (bf16*)(F.ws + WS_VT);
    float* CP = (float*)(F.ws + WS_CP); const float* TA = (const float*)(F.ws + WS_TA);
    LAS float* wbt = (LAS float*)(F.lds + L_SCR);
    { const float* CG = (const float*)(F.ws + WS_CG);
      float gq[4], aq[4];
#pragma unroll
      for (int i = 0; i < 4; ++i) { const int bh = F.wave + 8 * i; gq[i] = CG[(bh * 64 + F.lane) * 2]; aq[i] = CG[(bh * 64 + F.lane) * 2 + 1]; }
#pragma unroll
      for (int i = 0; i < 4; ++i) { const int bh = F.wave + 8 * i; const float g = gq[i];
        float p = g, q = g + aq[i];
#pragma unroll
        for (int o = 1; o < 64; o <<= 1) { const float pp = shfl_idx_l(p, (F.lane - o) & 63), qq = shfl_idx_l(q, (F.lane - o) & 63); if (F.lane >= o) { q = fmaxf(qq + p, q); p = pp + p; } }
        const float m_new = fmaxf(p, q);
        float m_prev = shfl_idx_l(m_new, (F.lane - 1) & 63); if (F.lane == 0) m_prev = 0.f;
        wbt[bh * 64 + F.lane] = g - m_new;
        if (F.wg == 0) { float* cp = CP + (bh * 64 + F.lane) * 4; cp[0] = m_prev; cp[1] = g - m_new; cp[2] = __expf(g + m_prev - m_new); cp[3] = 0.f; } }
    }
    __syncthreads();
    {
        const int hh0 = (F.wg >> 6) & 3;
        float wt[2][4][8], bs[2][8]; int tl_[2], d0_[2];
#pragma unroll
        for (int pp = 0; pp < 2; ++pp) { const int p = F.tid + 512 * pp, blk = p >> 6, slot = p & 63, kd = blk >> 1, th = blk & 1; tl_[pp] = 32 * th + (slot & 31); d0_[pp] = 16 * kd + 8 * (slot >> 5);
            const int c0 = 512 + 128 * hh0 + d0_[pp];
            { const f32x4 b0 = *(const GAS f32x4*)(cb + c0), b1 = *(const GAS f32x4*)(cb + c0 + 4); bs[pp][0] = b0.x; bs[pp][1] = b0.y; bs[pp][2] = b0.z; bs[pp][3] = b0.w; bs[pp][4] = b1.x; bs[pp][5] = b1.y; bs[pp][6] = b1.z; bs[pp][7] = b1.w; }
#pragma unroll
            for (int j = 0; j < 4; ++j) { const f32x4 w0 = *(const GAS f32x4*)(cw + j * 1024 + c0), w1 = *(const GAS f32x4*)(cw + j * 1024 + c0 + 4);
                wt[pp][j][0] = w0.x; wt[pp][j][1] = w0.y; wt[pp][j][2] = w0.z; wt[pp][j][3] = w0.w; wt[pp][j][4] = w1.x; wt[pp][j][5] = w1.y; wt[pp][j][6] = w1.z; wt[pp][j][7] = w1.w; } }
        v4u xn[2][4]; float tan_[2];
#define PREP_ISSUE(UN) do { const int bh_ = (UN) >> 6, c_ = (UN) & 63, b_ = bh_ >> 2, hh_ = bh_ & 3; _Pragma("unroll") for (int pp = 0; pp < 2; ++pp) { const int row_ = b_ * SEQ + 64 * c_ + tl_[pp], s_ = 64 * c_ + tl_[pp], c0_ = 512 + 128 * hh_ + d0_[pp]; \
            _Pragma("unroll") for (int j = 0; j < 4; ++j) { xn[pp][j] = (v4u){0u, 0u, 0u, 0u}; if (s_ - 3 + j >= 0) xn[pp][j] = *(const GAS v4u*)uf_piece(UF, row_ - 3 + j, c0_); } \
            tan_[pp] = TA[bh_ * SEQ + 64 * c_ + tl_[pp]]; } } while (0)
        if (F.wg < 2048) PREP_ISSUE(F.wg);
        for (int un = F.wg, buf = 0; un < 2048; un += F.G, buf ^= 1) {
            const int bh = un >> 6, c = un & 63, b = bh >> 2, hh = bh & 3;
            LAS unsigned char* tile = F.lds + buf * 17408;
            v4u x[2][4]; float ta[2];
#pragma unroll
            for (int pp = 0; pp < 2; ++pp) { ta[pp] = tan_[pp];
#pragma unroll
                for (int j = 0; j < 4; ++j) x[pp][j] = xn[pp][j]; }
            if (un + F.G < 2048) PREP_ISSUE(un + F.G);
#pragma unroll
            for (int pp = 0; pp < 2; ++pp) {
                const int tl = tl_[pp], d0 = d0_[pp], slot = (F.tid + 512 * pp) & 63, row = b * SEQ + 64 * c + tl, c0 = 512 + 128 * ((F.G == 256) ? hh0 : hh) + d0;
                float a[8];
#pragma unroll
                for (int e = 0; e < 8; ++e) a[e] = bs[pp][e];
#pragma unroll
                for (int j = 0; j < 4; ++j) { const v4u xx = x[pp][j];
                    a[0] += wt[pp][j][0] * bflo(xx.x); a[1] += wt[pp][j][1] * bfhi(xx.x); a[2] += wt[pp][j][2] * bflo(xx.y); a[3] += wt[pp][j][3] * bfhi(xx.y);
                    a[4] += wt[pp][j][4] * bflo(xx.z); a[5] += wt[pp][j][5] * bfhi(xx.z); a[6] += wt[pp][j][6] * bflo(xx.w); a[7] += wt[pp][j][7] * bfhi(xx.w); }
#pragma unroll
                for (int e = 0; e < 8; ++e) a[e] = a[e] * __builtin_amdgcn_rcpf(1.0f + __expf(-a[e])) * 0.08838834764831845f;
                v4u o; o.x = pk2(a[0], a[1]); o.y = pk2(a[2], a[3]); o.z = pk2(a[4], a[5]); o.w = pk2(a[6], a[7]);
                *(GAS v4u*)(KF + ((size_t)((c0 - 512) >> 4) * NRT + (row >> 5)) * 512 + slot * 8) = o;
                const float wsc = __expf(wbt[bh * 64 + c] + ta[pp]);
                o.x = pk2(a[0] * wsc, a[1] * wsc); o.y = pk2(a[2] * wsc, a[3] * wsc); o.z = pk2(a[4] * wsc, a[5] * wsc); o.w = pk2(a[6] * wsc, a[7] * wsc);
                *(LAS v4u*)(tile + tl * 272 + d0 * 2) = o;
            }
            __syncthreads();
#pragma unroll
            for (int pp = 0; pp < 2; ++pp) {
                const int p = F.tid + 512 * pp, ob = p >> 6, l = p & 63, rtile = ob & 3, tkl = ob >> 2, dd = 32 * rtile + (l & 31), t0 = 16 * tkl + 8 * (l >> 5);
                unsigned w[4];
#pragma unroll
                for (int i = 0; i < 4; ++i) { const unsigned lo = *(const LAS unsigned short*)(tile + (t0 + 2 * i) * 272 + dd * 2), hi = *(const LAS unsigned short*)(tile + (t0 + 2 * i + 1) * 272 + dd * 2); w[i] = lo | (hi << 16); }
                *(GAS v4u*)(KWF + (((size_t)bh * 4 + rtile) * 256 + 4 * c + tkl) * 512 + l * 8) = (v4u){w[0], w[1], w[2], w[3]};
            }
        }
#undef PREP_ISSUE
    }
    __syncthreads();
    for (int idx = F.wg * NTHREADS + F.tid; idx < 32 * 256 * 64; idx += F.G * NTHREADS) {
        const int bh = idx >> 14, tk = (idx >> 6) & 255, l = idx & 63; const unsigned v = (l & 31) == 0 ? 0x3F803F80u : 0u;
        *(GAS v4u*)(VF + (((size_t)bh * 9 + 8) * 256 + tk) * 512 + l * 8) = (v4u){v, v, v, v};
    }
}

constexpr int ST_D = 5, ST_SLOT = 24576, ST_WGS = 160;
#define ST_VMW(n) asm volatile("s_waitcnt vmcnt(" #n ")" ::: "memory")
__device__ __forceinline__ void st_stage(Frame& F, const bf16* KWF, const bf16* VF, int bh, int vt, int c, int slot) {
    LAS unsigned char* S = F.lds + slot * ST_SLOT;
#pragma unroll
    for (int k = 0; k < 2; ++k) { const int p = F.wave + 8 * k, dt = p >> 2, ks = p & 3;
        __builtin_amdgcn_global_load_lds((const unsigned*)(KWF + (((size_t)bh * 4 + dt) * 256 + 4 * c + ks) * 512 + F.lane * 8), (LAS unsigned*)(S + p * 1024), 16, 0, 0); }
    __builtin_amdgcn_global_load_lds((const unsigned*)(VF + (((size_t)bh * 9 + vt) * 256 + 4 * c + (F.wave & 3)) * 512 + F.lane * 8), (LAS unsigned*)(S + (16 + F.wave) * 1024), 16, 0, 0);
}
__device__ __forceinline__ void mlstm_state(Frame& F, const float* cw, const float* cb) {
    if (F.wg >= ST_WGS) { mlstm_qconv(F, cw, cb, ST_WGS); return; }
    const bf16* KWF = (const bf16*)(F.ws + WS_KT); const bf16* VF = (const bf16*)(F.ws + WS_VT); bf16* CTF = (bf16*)(F.ws + WS_CTS);
    const float* CP = (const float*)(F.ws + WS_CP);
    const int bh = F.wg / 5, pr = F.wg - 5 * bh, ug = F.wave >> 2, dt = F.wave & 3, r = F.lane & 31, hi = F.lane >> 5;
    const bool active = (pr < 4) || (ug == 0);
    const int vt = active ? 2 * pr + ug : 8;
    bf16* cts = CTF + ((((size_t)bh * 64) * 9 + vt) * 8 + 2 * dt + hi) * 512 + r * 8;
    const float csv = CP[(bh * 64 + F.lane) * 4 + 2];
    f32x16 acc;
#pragma unroll
    for (int i = 0; i < 16; ++i) acc[i] = 0.f;
    asm volatile("s_waitcnt vmcnt(0)" ::: "memory");
#pragma unroll
    for (int c = 0; c < ST_D - 1; ++c) st_stage(F, KWF, VF, bh, vt, c, c);
    for (int c = 0; c < 64; ++c) {
        if (!active || c == 0) ST_VMW(9); else if (c >= 4) ST_VMW(17); else if (c == 1) ST_VMW(11); else if (c == 2) ST_VMW(13); else ST_VMW(15);
        __builtin_amdgcn_s_barrier();
        const int slot = c % ST_D; const LAS unsigned char* S = F.lds + slot * ST_SLOT;
        v4u kb[4], vb[4];
#pragma unroll
        for (int ks = 0; ks < 4; ++ks) { kb[ks] = *(const LAS v4u*)(S + (dt * 4 + ks) * 1024 + F.lane * 16); vb[ks] = *(const LAS v4u*)(S + (16 + ug * 4 + ks) * 1024 + F.lane * 16); }
        LDS_WAIT(); asm volatile("" ::: "memory");
        { const int cn = c + ST_D - 1; st_stage(F, KWF, VF, bh, vt, cn < 64 ? cn : 63, cn % ST_D); }
        if (active) {
            { unsigned P[8];
#pragma unroll
              for (int g = 0; g < 8; ++g) P[g] = cvtpk(acc[2 * g], acc[2 * g + 1]);
              const auto s0 = __builtin_amdgcn_permlane32_swap(P[0], P[4], false, false), s1 = __builtin_amdgcn_permlane32_swap(P[1], P[5], false, false);
              const auto s2 = __builtin_amdgcn_permlane32_swap(P[2], P[6], false, false), s3 = __builtin_amdgcn_permlane32_swap(P[3], P[7], false, false);
              bf16* dst = cts + (size_t)c * 9 * 8 * 512;
              *(GAS v4u*)dst = (v4u){s0[0], s1[0], s0[1], s1[1]}; *(GAS v4u*)(dst + 32 * 8) = (v4u){s2[0], s3[0], s2[1], s3[1]}; }
            const float cs = __builtin_bit_cast(float, __builtin_amdgcn_readlane(__builtin_bit_cast(int, csv), c));
#pragma unroll
            for (int i = 0; i < 16; ++i) acc[i] *= cs;
#pragma unroll
            for (int ks = 0; ks < 4; ++ks) acc = MFMA32(__builtin_bit_cast(bf16x8_t, kb[ks]), __builtin_bit_cast(bf16x8_t, vb[ks]), acc);
        }
        asm volatile("" ::: "memory");
    }
    asm volatile("s_waitcnt vmcnt(0)" ::: "memory"); __syncthreads();
}
#undef ST_VMW

__device__ __forceinline__ void mo_stage(Frame& F, LAS unsigned char* S, const bf16* QF, const bf16* KF, const bf16* CTF, int bh, int c) {
    const int b = bh >> 2, hh = bh & 3, rt0 = b * 128 + 2 * c;
#pragma unroll
    for (int k = 0; k < 5; ++k) {
        const int blk = F.wave + 8 * k;
        const bf16* src = blk < 16 ? uf_block(QF, 8 * hh + (blk & 7), rt0 + (blk >> 3)) : (blk < 32 ? uf_block(KF, 8 * hh + (blk & 7), rt0 + ((blk - 16) >> 3)) : CTF + (((size_t)(bh * 64 + c) * 9 + 8) * 8 + (blk - 32)) * 512);
        __builtin_amdgcn_global_load_lds((const unsigned*)((const char*)src + F.lane * 16), (LAS unsigned*)(S + blk * 1024), 16, 0, 0);
    }
    if (F.wave < 3 && F.lane < 16) { const float* src = (const float*)(F.ws + (F.wave == 0 ? WS_TA : (F.wave == 1 ? WS_TU : WS_TM))) + bh * SEQ + 64 * c;
        __builtin_amdgcn_global_load_lds((const unsigned*)((const char*)src + F.lane * 16), (LAS unsigned*)(S + 40960 + F.wave * 256), 16, 0, 0); }
}
template <bool H8> __device__ __forceinline__ void mlstm_out(Frame& F, const float* mhg) {
    const bf16* UF = (const bf16*)(F.ws + WS_U); const bf16* QF = (const bf16*)(F.ws + WS_QF); const bf16* KF = (const bf16*)(F.ws + WS_KF); const bf16* VF = (const bf16*)(F.ws + WS_VT);
    const bf16* CTF = (const bf16*)(F.ws + WS_CTS); bf16* HM = (bf16*)(F.ws + WS_HM);
    const float* TA = (const float*)(F.ws + WS_TA); const float* TB = (const float*)(F.ws + WS_TU); const float* TP = (const float*)(F.ws + WS_TM); const float* CP = (const float*)(F.ws + WS_CP);
    constexpr int MO_STRIDE = 41984;
    LAS float* part = (LAS float*)(F.lds + 2 * MO_STRIDE);
    LAS float* mhl = part + 2 * 8 * 64;
    LAS float* qnl = mhl + 256;
    const int r = F.lane & 31, hi = F.lane >> 5, w = F.wave;
    const int unit0 = F.vwg * 8, bh = unit0 >> 6, c0 = unit0 & 63, b = bh >> 2, hh = bh & 3;
    int par = 0;
    mo_stage(F, F.lds, QF, KF, CTF, bh, c0);
    if (F.tid < 256) mhl[F.tid] = mhg[hh * 256 + F.tid];
    float m_next = CP[(bh * 64 + c0) * 4];
    bf16x8_t ncv[8]; v2u nvlo[2][2], nvhi[2][2];
#define MO_PRIV(cc) do { const bf16* ctv_ = CTF + (((size_t)(bh * 64 + (cc)) * 9 + w) * 8) * 512 + F.lane * 8; \
        _Pragma("unroll") for (int ks = 0; ks < 8; ++ks) ncv[ks] = __builtin_nontemporal_load((const GAS bf16x8_t*)(ctv_ + (size_t)ks * 512));   \
        const bf16* vfp_ = VF + (((size_t)bh * 9 + w) * 256 + 4 * (cc)) * 512 + r * 8 + 4 * hi; \
        _Pragma("unroll") for (int st = 0; st < 2; ++st) _Pragma("unroll") for (int sp = 0; sp < 2; ++sp) { const bf16* blk_ = vfp_ + (size_t)(2 * st + sp) * 512; nvlo[st][sp] = *(const GAS v2u*)blk_; nvhi[st][sp] = *(const GAS v2u*)(blk_ + 32 * 8); } } while (0)
    MO_PRIV(c0);
    for (int i = 0; i < 8; ++i) {
        const int c = c0 + i;
        LAS unsigned char* S = F.lds + (i & 1) * MO_STRIDE; const LAS float* SA = (const LAS float*)(S + 40960); const LAS float* SB = SA + 64; const LAS float* SP = SA + 128;
        asm volatile("s_waitcnt vmcnt(0)" ::: "memory"); __builtin_amdgcn_s_barrier(); asm volatile("" ::: "memory");
        if (i + 1 < 8) mo_stage(F, F.lds + ((i + 1) & 1) * MO_STRIDE, QF, KF, CTF, bh, c + 1);
        const size_t row0 = (size_t)b * SEQ + 64 * c; const int tb = bh * SEQ + 64 * c;
        const float m_prev = m_next; if (i + 1 < 8) m_next = CP[(bh * 64 + c + 1) * 4];
        bf16x8_t cv[8]; v2u vlo[2][2], vhi[2][2];
#pragma unroll
        for (int ks = 0; ks < 8; ++ks) cv[ks] = ncv[ks];
#pragma unroll
        for (int st = 0; st < 2; ++st)
#pragma unroll
            for (int sp = 0; sp < 2; ++sp) { vlo[st][sp] = nvlo[st][sp]; vhi[st][sp] = nvhi[st][sp]; }
        if (i + 1 < 8) MO_PRIV(c + 1);
        v2u og[2][4];
#pragma unroll
        for (int tt = 0; tt < 2; ++tt)
#pragma unroll
            for (int rg = 0; rg < 4; ++rg) og[tt][rg] = *(const GAS v2u*)(uf_piece(UF, (int)row0 + 32 * tt + r, 2048 + hh * 256 + 32 * w + 8 * rg + 4 * hi) + 4 * hi);
        f32x16 hv[2]; float dn[2];
#pragma unroll
        for (int tt = 0; tt < 2; ++tt) {
            const int t = 32 * tt + r; const float mx_t = fmaxf(m_prev, SP[t]), u_t = -mx_t, mt_t = SB[t] + mx_t;
            bf16x8_t qf[8];
#pragma unroll
            for (int ks = 0; ks < 8; ++ks) qf[ks] = *(const LAS bf16x8_t*)(S + (tt * 8 + ks) * 1024 + F.lane * 16);
            if (w == tt) {
                f32x16 accn;
#pragma unroll
                for (int q = 0; q < 16; ++q) accn[q] = 0.f;
#pragma unroll
                for (int g4 = 0; g4 < 2; ++g4) {
                    bf16x8_t nf[4];
#pragma unroll
                    for (int k = 0; k < 4; ++k) nf[k] = *(const LAS bf16x8_t*)(S + (32 + 4 * g4 + k) * 1024 + F.lane * 16);
                    __builtin_amdgcn_sched_group_barrier(0x100, 4, 0);
#pragma unroll
                    for (int k = 0; k < 4; ++k) accn = MFMA32(nf[k], qf[4 * g4 + k], accn);
                    __builtin_amdgcn_sched_group_barrier(0x008, 4, 0);
                }
                if (hi == 0) qnl[par * 64 + t] = accn[0];
            }
            __builtin_amdgcn_sched_barrier(0);
            f32x16 acc; float den = 0.f;
#pragma unroll
            for (int q = 0; q < 16; ++q) acc[q] = 0.f;
#pragma unroll
            for (int st = 0; st <= tt; ++st) {
                __builtin_amdgcn_sched_barrier(0);
                f32x16 X;
#pragma unroll
                for (int q = 0; q < 16; ++q) X[q] = 0.f;
#pragma unroll
                for (int g4 = 0; g4 < 2; ++g4) {
                    bf16x8_t kf[4];
#pragma unroll
                    for (int k = 0; k < 4; ++k) kf[k] = *(const LAS bf16x8_t*)(S + (16 + st * 8 + 4 * g4 + k) * 1024 + F.lane * 16);
                    __builtin_amdgcn_sched_group_barrier(0x100, 4, 0);
#pragma unroll
                    for (int k = 0; k < 4; ++k) X = MFMA32(kf[k], qf[4 * g4 + k], X);
                    __builtin_amdgcn_sched_group_barrier(0x008, 4, 0);
                }
#pragma unroll
                for (int rg = 0; rg < 4; ++rg) { const f32x4 av = *(const LAS f32x4*)(SA + 32 * st + 8 * rg + 4 * hi);
#pragma unroll
                    for (int e = 0; e < 4; ++e) { const int s = 32 * st + 8 * rg + 4 * hi + e; const float val = (s <= t) ? X[4 * rg + e] * __expf(u_t + av[e]) : 0.f; X[4 * rg + e] = val; den += val; } }
#pragma unroll
                for (int sp = 0; sp < 2; ++sp) {
                    const bf16x8_t pf = mk_frag(cvtpk(X[8 * sp], X[8 * sp + 1]), cvtpk(X[8 * sp + 2], X[8 * sp + 3]), cvtpk(X[8 * sp + 4], X[8 * sp + 5]), cvtpk(X[8 * sp + 6], X[8 * sp + 7]));
                    acc = MFMA32(mk_frag(vlo[st][sp].x, vlo[st][sp].y, vhi[st][sp].x, vhi[st][sp].y), pf, acc);
                }
            }
            __builtin_amdgcn_sched_barrier(0);
            const float is = __expf(u_t + m_prev);
            f32x16 acc2;
#pragma unroll
            for (int q = 0; q < 16; ++q) acc2[q] = 0.f;
#pragma unroll
            for (int ks = 0; ks < 8; ++ks) acc2 = MFMA32(cv[ks], qf[ks], acc2);
            __builtin_amdgcn_sched_barrier(0);
            den = xh_sum(den);
            dn[tt] = den;
            float ssq = 0.f;
#pragma unroll
            for (int q = 0; q < 16; ++q) { const float h = acc[q] + is * acc2[q]; hv[tt][q] = h; ssq += h * h; }
            ssq = xh_sum(ssq);
            if (hi == 0) part[(par * 8 + w) * 64 + t] = ssq;
        }
        asm volatile("s_waitcnt lgkmcnt(0)" ::: "memory"); __builtin_amdgcn_s_barrier(); asm volatile("" ::: "memory");
#pragma unroll
        for (int tt = 0; tt < 2; ++tt) {
            const int t = 32 * tt + r; float tot = 0.f;
#pragma unroll
            for (int ww = 0; ww < 8; ++ww) tot += part[(par * 8 + ww) * 64 + t];
            const float mx_t = fmaxf(m_prev, SP[t]); const float inv = 1.0f / fmaxf(fabsf(dn[tt] + __expf(m_prev - mx_t) * qnl[par * 64 + t]), __expf(-(SB[t] + mx_t)));
            const float rs = inv / sqrtf(tot * inv * inv * (1.0f / 256.0f) + EPS);
            const int row = (int)row0 + t;
            unsigned P[8];
#pragma unroll
            for (int rg = 0; rg < 4; ++rg) { const int v0 = hh * 256 + 32 * w + 8 * rg + 4 * hi;
                const f32x4 g4 = *(const LAS f32x4*)(mhl + 32 * w + 8 * rg + 4 * hi); const v2u ow = og[tt][rg];
                const float y0 = hv[tt][4 * rg] * rs * g4.x * __builtin_amdgcn_rcpf(1.0f + __expf(-bflo(ow.x))), y1 = hv[tt][4 * rg + 1] * rs * g4.y * __builtin_amdgcn_rcpf(1.0f + __expf(-bfhi(ow.x)));
                const float y2 = hv[tt][4 * rg + 2] * rs * g4.z * __builtin_amdgcn_rcpf(1.0f + __expf(-bflo(ow.y))), y3 = hv[tt][4 * rg + 3] * rs * g4.w * __builtin_amdgcn_rcpf(1.0f + __expf(-bfhi(ow.y)));
                if constexpr (H8) P[rg] = pg8::pk4_f8(y0 * X_SCALE, y1 * X_SCALE, y2 * X_SCALE, y3 * X_SCALE); else { P[2 * rg] = cvtpk(y0, y1); P[2 * rg + 1] = cvtpk(y2, y3); } }
            if constexpr (H8) {
                const auto s0 = __builtin_amdgcn_permlane32_swap(P[0], P[2], false, false), s1 = __builtin_amdgcn_permlane32_swap(P[1], P[3], false, false);
                *(GAS v4u*)((unsigned char*)HM + (size_t)row * D + hh * 256 + 32 * w + 16 * hi) = (v4u){s0[0], s0[1], s1[0], s1[1]};
            } else {
            const auto s0 = __builtin_amdgcn_permlane32_swap(P[0], P[4], false, false), s1 = __builtin_amdgcn_permlane32_swap(P[1], P[5], false, false);
            const auto s2 = __builtin_amdgcn_permlane32_swap(P[2], P[6], false, false), s3 = __builtin_amdgcn_permlane32_swap(P[3], P[7], false, false);
            GAS v4u* dst = (GAS v4u*)(HM + (size_t)row * D + hh * 256 + 32 * w + 16 * hi);
            dst[0] = (v4u){s0[0], s1[0], s0[1], s1[1]}; dst[1] = (v4u){s2[0], s3[0], s2[1], s3[1]}; }
        }
        par ^= 1;
    }
#undef MO_PRIV
    asm volatile("s_waitcnt vmcnt(0)" ::: "memory"); __syncthreads();
}
__device__ __forceinline__ void attn_prep(Frame& F) {
    const bf16* UF = (const bf16*)(F.ws + WS_U); bf16* VTF = (bf16*)(F.ws + WS_VTA);
    const int bi = F.tid >> 6, l = F.lane;
    const int st = 32 * (bi & 1) + (l & 31), sd = 16 * (bi >> 1) + 8 * (l >> 5);
    const int odt = bi & 1, otk = bi >> 1, od = 32 * odt + (l & 31), ot = 16 * otk + 8 * (l >> 5);
    v4u cur = (v4u){0u, 0u, 0u, 0u};
    { const int un = F.wg; const int b = un >> 10, h16 = (un >> 6) & 15, tb = un & 63; const int vcb = (h16 < 8 ? 1024 + 64 * h16 : 2560 + 64 * (h16 - 8)) >> 4;
      cur = *(const GAS v4u*)(uf_block(UF, vcb + (bi >> 1), b * 128 + 2 * tb + (bi & 1)) + l * 8); }
    int buf = 0;
    for (int un = F.wg; un < 8192; un += F.G) {
        const int b = un >> 10, h16 = (un >> 6) & 15, tb = un & 63;
        LAS unsigned char* tile = F.lds + buf * 9216;
        *(LAS v4u*)(tile + st * 144 + sd * 2) = cur;
        const int nx = un + F.G;
        if (nx < 8192) { const int b2 = nx >> 10, h2 = (nx >> 6) & 15, tb2 = nx & 63; const int vcb = (h2 < 8 ? 1024 + 64 * h2 : 2560 + 64 * (h2 - 8)) >> 4;
            cur = *(const GAS v4u*)(uf_block(UF, vcb + (bi >> 1), b2 * 128 + 2 * tb2 + (bi & 1)) + l * 8); }
        __syncthreads();
        unsigned w[4];
#pragma unroll
        for (int i = 0; i < 4; ++i) { const unsigned lo = *(const LAS unsigned short*)(tile + (ot + 2 * i) * 144 + od * 2), hi = *(const LAS unsigned short*)(tile + (ot + 2 * i + 1) * 144 + od * 2); w[i] = lo | (hi << 16); }
        *(GAS v4u*)(VTF + ((((size_t)b * 16 + h16) * 2 + odt) * 256 + 4 * tb + otk) * 512 + l * 8) = (v4u){w[0], w[1], w[2], w[3]};
        buf ^= 1;
    }
    __syncthreads();
}
struct VFrag { v2u lo[2][2], hi[2][2]; };
__device__ __forceinline__ void load_v(VFrag& v, const bf16* vtf, int r, int hi) {
#pragma unroll
    for (int sp = 0; sp < 2; ++sp)
#pragma unroll
        for (int dt = 0; dt < 2; ++dt) { const bf16* blk = vtf + ((size_t)dt * 256 + sp) * 512; v.lo[sp][dt] = *(const GAS v2u*)(blk + r * 8 + 4 * hi); v.hi[sp][dt] = *(const GAS v2u*)(blk + (r + 32) * 8 + 4 * hi); }
}
__device__ __forceinline__ void pv_tile(f32x16 (&oacc)[2], const float (&p)[16], const VFrag& v) {
#pragma unroll
    for (int sp = 0; sp < 2; ++sp) {
        const bf16x8_t pf = mk_frag(cvtpk(p[8 * sp], p[8 * sp + 1]), cvtpk(p[8 * sp + 2], p[8 * sp + 3]), cvtpk(p[8 * sp + 4], p[8 * sp + 5]), cvtpk(p[8 * sp + 6], p[8 * sp + 7]));
#pragma unroll
        for (int dt = 0; dt < 2; ++dt) oacc[dt] = MFMA32(mk_frag(v.lo[sp][dt].x, v.lo[sp][dt].y, v.hi[sp][dt].x, v.hi[sp][dt].y), pf, oacc[dt]);
    }
}
template <bool O8> __device__ __forceinline__ void store_ot(bf16* orow  , const f32x16 (&oacc)[2], float scale) {
    if constexpr (O8) {
#pragma unroll
        for (int dt = 0; dt < 2; ++dt) { unsigned Q[4]; const float sc = scale * X_SCALE;
#pragma unroll
            for (int g = 0; g < 4; ++g) Q[g] = pg8::pk4_f8(oacc[dt][4 * g] * sc, oacc[dt][4 * g + 1] * sc, oacc[dt][4 * g + 2] * sc, oacc[dt][4 * g + 3] * sc);
            const auto s0 = __builtin_amdgcn_permlane32_swap(Q[0], Q[2], false, false), s1 = __builtin_amdgcn_permlane32_swap(Q[1], Q[3], false, false);
            *(GAS v4u*)((unsigned char*)orow + 32 * dt) = (v4u){s0[0], s0[1], s1[0], s1[1]}; }
        return;
    }
#pragma unroll
    for (int dt = 0; dt < 2; ++dt) { unsigned P[8];
#pragma unroll
        for (int g = 0; g < 8; ++g) P[g] = cvtpk(oacc[dt][2 * g] * scale, oacc[dt][2 * g + 1] * scale);
        const auto s0 = __builtin_amdgcn_permlane32_swap(P[0], P[4], false, false), s1 = __builtin_amdgcn_permlane32_swap(P[1], P[5], false, false);
        const auto s2 = __builtin_amdgcn_permlane32_swap(P[2], P[6], false, false), s3 = __builtin_amdgcn_permlane32_swap(P[3], P[7], false, false);
        GAS v4u* dst = (GAS v4u*)(orow + 32 * dt);
        dst[0] = (v4u){s0[0], s1[0], s0[1], s1[1]}; dst[1] = (v4u){s2[0], s3[0], s2[1], s3[1]}; }
}
constexpr float ATT_C2 = 0.125f * 1.4426950408889634f;
template <bool MASKED> __device__ __forceinline__ void sb_weights(const f32x16& X, int kt, int t, int hi, int lane, float& run, float (&p)[16]) {
    float lb[16], la[16], G[4];
#pragma unroll
    for (int rg = 0; rg < 4; ++rg) { float g = 0.f;
#pragma unroll
        for (int e = 0; e < 4; ++e) { const int q = 4 * rg + e; const float z = X[q] * ATT_C2;
            const float sp = fmaxf(z, 0.f) + __builtin_amdgcn_logf(1.0f + __builtin_amdgcn_exp2f(-fabsf(z)));
            if (MASKED) { const int s_ = 32 * kt + 8 * rg + 4 * hi + e; const bool valid = s_ < t; lb[q] = valid ? -sp : 0.f; la[q] = valid ? z - sp : -INFINITY; }
            else { lb[q] = -sp; la[q] = z - sp; }
            g += lb[q]; }
        G[rg] = g; }
    float Go[4];
#pragma unroll
    for (int rg = 0; rg < 4; ++rg) Go[rg] = xh_other(G[rg], hi);
    float suf = run;
#pragma unroll
    for (int rg = 3; rg >= 0; --rg) {
        const float above = suf + (hi == 0 ? Go[rg] : 0.f);
        float inner = 0.f;
#pragma unroll
        for (int e = 3; e >= 0; --e) { const int q = 4 * rg + e; p[q] = __builtin_amdgcn_exp2f(la[q] + above + inner); inner += lb[q]; }
        suf += G[rg] + Go[rg];
    }
    run = suf;
}
template <bool O8> __device__ __forceinline__ void attn_mfma(Frame& F, const float* relb  ) {
    const bf16* UF = (const bf16*)(F.ws + WS_U); const bf16* VTF = (const bf16*)(F.ws + WS_VTA); bf16* O = (bf16*)(F.ws + WS_O);
    LAS float* bl = (LAS float*)(F.lds + F.wave * 2304);
    const int gw = F.vwg * NWAVES + F.wave, bh = gw >> 5, sub = gw & 31, b = bh >> 3, h = bh & 7, r = F.lane & 31, hi = F.lane >> 5;
    const size_t rowbase = (size_t)b * SEQ;
    for (int i = F.lane; i < 513; i += 64) bl[i] = relb[h * 513 + i] * 1.4426950408889634f;
    LDS_WAIT(); asm volatile("" ::: "memory");
    for (int uu = 0; uu < 4; ++uu) {
        const int qt = 4 * sub + uu, t = 32 * qt + r;
        bf16x8_t qf[4];
#pragma unroll
        for (int ks = 0; ks < 4; ++ks) qf[ks] = *(const GAS bf16x8_t*)(uf_block(UF, 4 * h + ks, b * 128 + qt) + F.lane * 8);
        f32x16 oacc[2];
#pragma unroll
        for (int q = 0; q < 16; ++q) { oacc[0][q] = 0.f; oacc[1][q] = 0.f; }
        float run = 0.f;
        const bf16* vt0 = VTF + (((size_t)b * 16 + h) * 2) * 256 * 512;
        bf16x8_t kn[4];
#pragma unroll
        for (int ks = 0; ks < 4; ++ks) kn[ks] = *(const GAS bf16x8_t*)(uf_block(UF, 32 + 4 * h + ks, b * 128 + qt) + F.lane * 8);
        for (int kt = qt; kt >= 0; --kt) {
            bf16x8_t kf[4]; VFrag vf;
#pragma unroll
            for (int ks = 0; ks < 4; ++ks) kf[ks] = kn[ks];
            load_v(vf, vt0 + (size_t)(2 * kt) * 512, r, hi);
            if (kt > 0) {
#pragma unroll
                for (int ks = 0; ks < 4; ++ks) kn[ks] = *(const GAS bf16x8_t*)(uf_block(UF, 32 + 4 * h + ks, b * 128 + kt - 1) + F.lane * 8); }
            f32x16 X;
#pragma unroll
            for (int q = 0; q < 16; ++q) X[q] = 0.f;
#pragma unroll
            for (int ks = 0; ks < 4; ++ks) X = MFMA32(kf[ks], qf[ks], X);
            float p[16];
            if (kt == qt) sb_weights<true>(X, kt, t, hi, F.lane, run, p); else sb_weights<false>(X, kt, t, hi, F.lane, run, p);
            pv_tile(oacc, p, vf);
            if (__all(run < -158.7f)) break;
        }
        store_ot<O8>(O8 ? (bf16*)((unsigned char*)O + (rowbase + t) * D + h * 64 + 16 * hi) : O + (rowbase + t) * D + h * 64 + 16 * hi, oacc, 1.0f);
    }
    for (int uu = 0; uu < 2; ++uu) {
        const int c = 2 * sub + uu, tA = 64 * c + r, tB = tA + 32;
        bf16x8_t qa[4], qb[4];
#pragma unroll
        for (int ks = 0; ks < 4; ++ks) { qa[ks] = *(const GAS bf16x8_t*)(uf_block(UF, 96 + 4 * h + ks, b * 128 + 2 * c) + F.lane * 8); qb[ks] = *(const GAS bf16x8_t*)(uf_block(UF, 96 + 4 * h + ks, b * 128 + 2 * c + 1) + F.lane * 8); }
        f32x16 oa[2], ob[2];
#pragma unroll
        for (int q = 0; q < 16; ++q) { oa[0][q] = 0.f; oa[1][q] = 0.f; ob[0][q] = 0.f; ob[1][q] = 0.f; }
        float ma = -INFINITY, la = 0.f, mb = -INFINITY, lb2 = 0.f;
        const bf16* vt0 = VTF + (((size_t)b * 16 + 8 + h) * 2) * 256 * 512;
        const int kt0 = (c >= 8) ? 2 * (c - 8) : 0;
        bf16x8_t kn[4];
#pragma unroll
        for (int ks = 0; ks < 4; ++ks) kn[ks] = *(const GAS bf16x8_t*)(uf_block(UF, 128 + 4 * h + ks, b * 128 + kt0) + F.lane * 8);
        for (int kt = kt0; kt <= 2 * c + 1; ++kt) {
            bf16x8_t kf[4]; VFrag vf;
#pragma unroll
            for (int ks = 0; ks < 4; ++ks) kf[ks] = kn[ks];
            load_v(vf, vt0 + (size_t)(2 * kt) * 512, r, hi);
            if (kt < 2 * c + 1) {
#pragma unroll
                for (int ks = 0; ks < 4; ++ks) kn[ks] = *(const GAS bf16x8_t*)(uf_block(UF, 128 + 4 * h + ks, b * 128 + kt + 1) + F.lane * 8); }
            f32x16 XA, XB;
#pragma unroll
            for (int q = 0; q < 16; ++q) { XA[q] = 0.f; XB[q] = 0.f; }
#pragma unroll
            for (int ks = 0; ks < 4; ++ks) { XA = MFMA32(kf[ks], qa[ks], XA); XB = MFMA32(kf[ks], qb[ks], XB); }
            float xa[16], xb[16]; float mxa = -INFINITY, mxb = -INFINITY;
            if (kt <= 2 * c - 9) {
                const float bfar = bl[512];
#pragma unroll
                for (int q = 0; q < 16; ++q) { xa[q] = XA[q] * ATT_C2 + bfar; mxa = fmaxf(mxa, xa[q]); xb[q] = XB[q] * ATT_C2 + bfar; mxb = fmaxf(mxb, xb[q]); }
            } else {
#pragma unroll
                for (int q = 0; q < 16; ++q) { const int s = 32 * kt + (q & 3) + 8 * (q >> 2) + 4 * hi; int ra = tA - s; ra = ra < -256 ? -256 : (ra > 256 ? 256 : ra); int rb = tB - s; rb = rb < -256 ? -256 : (rb > 256 ? 256 : rb);
                    xa[q] = XA[q] * ATT_C2 + bl[ra + 256]; mxa = fmaxf(mxa, xa[q]); xb[q] = XB[q] * ATT_C2 + bl[rb + 256]; mxb = fmaxf(mxb, xb[q]); }
            }
            mxa = xh_max(mxa); mxb = xh_max(mxb);
            if (__any(mxa > ma + 8.0f || mxb > mb + 8.0f)) {
                const float mna = fmaxf(ma, mxa), ala = __builtin_amdgcn_exp2f(ma - mna), mnb = fmaxf(mb, mxb), alb = __builtin_amdgcn_exp2f(mb - mnb); ma = mna; mb = mnb;
                la *= ala; lb2 *= alb;
#pragma unroll
                for (int q = 0; q < 16; ++q) { oa[0][q] *= ala; oa[1][q] *= ala; ob[0][q] *= alb; ob[1][q] *= alb; }
            }
            float pa[16], pb[16]; float psa = 0.f, psb = 0.f;
#pragma unroll
            for (int q = 0; q < 16; ++q) { pa[q] = __builtin_amdgcn_exp2f(xa[q] - ma); psa += pa[q]; pb[q] = __builtin_amdgcn_exp2f(xb[q] - mb); psb += pb[q]; }
            psa = xh_sum(psa); psb = xh_sum(psb);
            la += psa; lb2 += psb;
            pv_tile(oa, pa, vf); pv_tile(ob, pb, vf);
        }
        store_ot<O8>(O8 ? (bf16*)((unsigned char*)O + (rowbase + tA) * D + 512 + h * 64 + 16 * hi) : O + (rowbase + tA) * D + 512 + h * 64 + 16 * hi, oa, 1.0f / la);
        store_ot<O8>(O8 ? (bf16*)((unsigned char*)O + (rowbase + tB) * D + 512 + h * 64 + 16 * hi) : O + (rowbase + tB) * D + 512 + h * 64 + 16 * hi, ob, 1.0f / lb2);
    }
}

struct Args { const float* in[23]; float* out; unsigned char* ws; int ph_lo, ph_hi, li, pad; };
#if MK_PER_PHASE
#define IN(k) (lo <= (k) && (k) < hi)
#else
#define IN(k) true
#endif
#define INP(i) ((const float*)ldptr(F, (i)))
#define HOUT ((float*)ldptr(F, 23))
#define H ((bf16*)(F.ws + WS_HB))
#define SEAM(k) do { if (IN(k) && IN((k) + 1)) xcd_barrier(bar); RELANE(); } while (0)
#define RELANE() do { int t_ = threadIdx.x; asm volatile("" : "+v"(t_)); F.tid = t_; F.lane = t_ & 63; F.wave = __builtin_amdgcn_readfirstlane(t_ >> 6); } while (0)
template <int j> __device__ __forceinline__ void layer_pair(Frame& F, const XcdBarrier& bar, const int lo, const int hi) {
    bf16* XN = (bf16*)(F.ws + WS_XN);
    LAS unsigned char* ring = F.lds;
        const int pb = j * NPH_PAIR;
        constexpr bool F8D = (j == 1) && DENSE_F8_L2, L8 = (j == 1) && LATE_F8, LQ = L8 && LATE_QKV, LI = L8 && LATE_INP, LO = L8 && LATE_OUT; constexpr float L8S = 1.0f / (X_SCALE * W_GU_SCALE);
        if (IN(pb + 0)) {
            if (j == 0) { convert_even<F8D, LQ, LO>(F, INP(2) + (size_t)j * D * NQKV, INP(4) + (size_t)j * D * D, INP(6) + (size_t)j * D * DFF, INP(7) + (size_t)j * D * DFF, INP(8) + (size_t)j * DFF * D);
            __syncthreads(); }
            if (j == 0) norm_phase<false, 0, false, true>(F, INP(0), H, INP(1), XN, nullptr, nullptr, nullptr, nullptr);
            else        norm_phase<true, 0, LQ>(F, H, H, INP(1) + D, XN, nullptr, nullptr, nullptr, nullptr);
        }
        SEAM(pb + 0);
        if (IN(pb + 1)) {
            pg8::Gemm g{XN, (const bf16*)(F.ws + WS_WQKV), T, NQKV, LQ ? D / 2 : D};
            { typedef pg8::LutOrder<0x98763210ull, 8> QK; QK S; S.init(T, F.G, F.wg);
              pg8::EpiStoreTiled E{(bf16*)(F.ws + WS_U), T / 32, LQ ? L8S : 1.0f};
              pg8::gemm_phase<pg8::EpiStoreTiled, QK, true, true, LQ>(ring, g, S, E); }
            { typedef pg8::LutOrder<0xBA54ull, 4> VV; VV S; S.init(T, F.G, F.wg);
              pg8::EpiStoreVT<false> E{(bf16*)(F.ws + WS_VTA), LQ ? L8S : 1.0f};
              pg8::gemm_phase<pg8::EpiStoreVT<false>, VV, true, true, LQ, true>(ring, g, S, E); }
        }
        SEAM(pb + 1);
        if (IN(pb + 3)) { attn_mfma<LO>(F, INP(3) + (size_t)j * 8 * 513); }
        SEAM(pb + 3);
        if (IN(pb + 4)) {
            pg8::Gemm g{(const bf16*)(F.ws + WS_O), (const bf16*)(F.ws + WS_WO), T, D, LO ? D / 2 : D}; pg8::StaticOrder S; S.init(T, D, F.G, F.wg);
            pg8::EpiResidH<j == 0> E{j == 0 ? (const void*)INP(0) : (const void*)H, H, D, LO ? L8S : 1.0f};
            pg8::gemm_phase<pg8::EpiResidH<j == 0>, pg8::StaticOrder, true, true, LO>(ring, g, S, E);
        }
        SEAM(pb + 4);
        if (IN(pb + 5)) { norm_phase<false, F8D ? 4 : 0>(F, H, H, INP(5) + (size_t)j * D, XN, nullptr, nullptr, nullptr, nullptr); }
        SEAM(pb + 5);
        if (IN(pb + 6)) {
            pg8::StaticOrder S; S.init(T, 2 * DFF, F.G, F.wg);
            if constexpr (F8D) {
                pg8::Gemm g{XN, (const bf16*)(F.ws + WS_WGU), T, 2 * DFF, D / 2};
                pg8::EpiSwiGLUF8 E{F.ws + WS_ACT, DFF, 1.0f / (X_SCALE * W_GU_SCALE), ACT_SCALE};
                pg8::gemm_phase<pg8::EpiSwiGLUF8, pg8::StaticOrder, true, true, true>(ring, g, S, E);
            } else {
                pg8::Gemm g{XN, (const bf16*)(F.ws + WS_WGU), T, 2 * DFF, D};
                pg8::EpiSwiGLU E{(bf16*)(F.ws + WS_ACT), DFF};
                pg8::gemm_phase<pg8::EpiSwiGLU, pg8::StaticOrder, true, true>(ring, g, S, E);
            }
        }
        SEAM(pb + 6);
        if (IN(pb + 7)) {
            pg8::StaticOrder S; S.init(T, D, F.G, F.wg);
            if constexpr (F8D) {
                pg8::Gemm g{(const bf16*)(F.ws + WS_ACT), (const bf16*)(F.ws + WS_WD), T, D, DFF / 2};
                pg8::EpiResidH<false> E{H, H, D, 1.0f / (ACT_SCALE * W_D_SCALE)};
                pg8::gemm_phase<pg8::EpiResidH<false>, pg8::StaticOrder, true, true, true>(ring, g, S, E);
            } else {
                pg8::Gemm g{(const bf16*)(F.ws + WS_ACT), (const bf16*)(F.ws + WS_WD), T, D, DFF};
                pg8::EpiResidH<false> E{H, H, D, 1.0f};
                pg8::gemm_phase<pg8::EpiResidH<false>, pg8::StaticOrder, true, true>(ring, g, S, E);
            }
        }
        SEAM(pb + 7);
        if (IN(pb + 8)) {
            convert_odd<LI, LO>(F, INP(10) + (size_t)j * D * MLW, INP(16) + (size_t)j * D * D, INP(19) + (size_t)j * NEXP * D * DFFE, INP(20) + (size_t)j * NEXP * D * DFFE, INP(21) + (size_t)j * NEXP * DFFE * D);
            __syncthreads();
            norm_phase<false, 1, LI>(F, H, H, INP(9) + (size_t)j * D, XN, nullptr, INP(10) + (size_t)j * D * MLW, INP(13) + j * 4, INP(14) + j * 4);
        }
        SEAM(pb + 8);
        if (IN(pb + 9)) {
            mlstm_scalars(F); __syncthreads();
            pg8::Gemm g{XN, (const bf16*)(F.ws + WS_WIN), T, NQKV, LI ? D / 2 : D};
            { typedef pg8::LutOrder<0xBA983210ull, 8> QO; QO S; S.init(T, F.G, F.wg);
              pg8::EpiStoreTiled E{(bf16*)(F.ws + WS_U), T / 32, LI ? L8S : 1.0f};
              pg8::gemm_phase<pg8::EpiStoreTiled, QO, true, true, LI>(ring, g, S, E); }
            { typedef pg8::LutOrder<0x7654ull, 4> VV; VV S; S.init(T, F.G, F.wg);
              pg8::EpiStoreVT<true> E{(bf16*)(F.ws + WS_VT), LI ? L8S : 1.0f};
              pg8::gemm_phase<pg8::EpiStoreVT<true>, VV, true, true, LI, true>(ring, g, S, E); }
        }
        SEAM(pb + 9);
        if (IN(pb + 10)) { mlstm_prep(F, INP(11) + (size_t)j * 4 * D, INP(12) + (size_t)j * D); }
        SEAM(pb + 10);
        if (IN(pb + 11)) { mlstm_state(F, INP(11) + (size_t)j * 4 * D, INP(12) + (size_t)j * D); }
        SEAM(pb + 11);
        if (IN(pb + 12)) { mlstm_out<LO>(F, INP(15) + (size_t)j * D); }
        SEAM(pb + 12);
        if (IN(pb + 13)) {
            pg8::Gemm g{(const bf16*)(F.ws + WS_HM), (const bf16*)(F.ws + WS_WO), T, D, LO ? D / 2 : D}; pg8::StaticOrder S; S.init(T, D, F.G, F.wg);
            pg8::EpiResidH<false> E{H, H, D, LO ? L8S : 1.0f};
            pg8::gemm_phase<pg8::EpiResidH<false>, pg8::StaticOrder, true, true, LO>(ring, g, S, E);
        }
        SEAM(pb + 13);
        if (IN(pb + 14)) { norm_phase<false, 2, true>(F, H, H, INP(17) + (size_t)j * D, XN, nullptr, INP(18) + (size_t)j * D * NEXP, nullptr, nullptr); }
        SEAM(pb + 14);
        if (IN(pb + 15)) { moe_assign_gather(F); }
        SEAM(pb + 15);
        if (IN(pb + 16)) {
            const int nt = moe_tile_table(F);
            pg8::Gemm g{(const bf16*)(F.ws + WS_XG), (const bf16*)(F.ws + WS_WEGU), 0, 0, D / 2};
            pg8::MoeOrder S{nt, 28, F.G, F.wg, 0, (const LAS int*)(F.lds + L_TEXP)};
            pg8::EpiSwiGLUF8NT E{F.ws + WS_ACTM, DFFE, 1.0f / (X_SCALE * W_GU_SCALE), ACT_SCALE};
            pg8::gemm_phase<pg8::EpiSwiGLUF8NT, pg8::MoeOrder, true, true, true>(ring, g, S, E);
        }
        SEAM(pb + 16);
        if (IN(pb + 17)) {
            const int nt = moe_tile_table(F);
            pg8::Gemm g{(const bf16*)(F.ws + WS_ACTM), (const bf16*)(F.ws + WS_WED), 0, 0, DFFE / 2};
            pg8::MoeOrder S{nt, 4, F.G, F.wg, 0, (const LAS int*)(F.lds + L_TEXP)};
            pg8::EpiStoreBf16S E{(bf16*)(F.ws + WS_Y), D, 1.0f / (ACT_SCALE * W_D_SCALE)};
            pg8::gemm_phase<pg8::EpiStoreBf16S, pg8::MoeOrder, true, true, true>(ring, g, S, E);
            if (j == 0) {
                constexpr bool F8Dn = DENSE_F8_L2 != 0, L8n = LATE_F8 != 0, LQn = L8n && LATE_QKV, LOn = L8n && LATE_OUT;
                int extra = nt * 4 - 4 * F.G; extra = extra < 0 ? 0 : (extra > F.G / 2 ? F.G / 2 : extra);
                __syncthreads();
                convert_even<F8Dn, LQn, LOn>(F, INP(2) + (size_t)1 * D * NQKV, INP(4) + (size_t)1 * D * D, INP(6) + (size_t)1 * D * DFF, INP(7) + (size_t)1 * D * DFF, INP(8) + (size_t)1 * DFF * D, extra);
            }
        }
        SEAM(pb + 17);
}

__global__ void __launch_bounds__(NTHREADS, 2) fwd_kernel(Args args) {
    extern __shared__ __attribute__((aligned(16))) unsigned char lds[];
    Frame F;
    F.lds = (LAS unsigned char*)lds; F.MISC = (volatile LAS unsigned*)(F.lds + L_MISC);
    F.tid = threadIdx.x; F.lane = F.tid & 63; F.wave = __builtin_amdgcn_readfirstlane(F.tid >> 6); F.wg = blockIdx.x; F.G = gridDim.x; F.ws = args.ws; F.vwg = (F.G % 8 == 0) ? (F.wg % 8) * (F.G / 8) + F.wg / 8 : F.wg;
    for (int u = F.tid; u < (LDS_BYTES - LDSCTL_OFF) / 4; u += NTHREADS) ((LAS unsigned*)(F.lds + LDSCTL_OFF))[u] = 0u;
    __syncthreads();
    if (F.tid < 23) ((LAS unsigned long long*)(F.lds + L_PTR))[F.tid] = (unsigned long long)args.in[F.tid];
    if (F.tid == 23) ((LAS unsigned long long*)(F.lds + L_PTR))[23] = (unsigned long long)args.out;
    __syncthreads();
    const int lo = args.ph_lo, hi = args.ph_hi;
    gu32* ctl = (gu32*)(args.ws + WS_CTL);
    XcdBarrier bar; bar.bar = (unsigned*)(ctl + CW_BAR) + args.li * XCD_BAR_WORDS; bar.x = 0; bar.st = nullptr;
    if (hi - lo > 1) bar = xcd_barrier_post((unsigned*)(ctl + CW_BAR) + args.li * XCD_BAR_WORDS, F.MISC + 8);
    layer_pair<0>(F, bar, lo, hi);
    layer_pair<1>(F, bar, lo, hi);
    if (IN(2 * NPH_PAIR)) { norm_phase<true, 3>(F, H, H, INP(22), nullptr, HOUT, nullptr, nullptr, nullptr); }
#undef IN
#undef INP
#undef HOUT
#undef H
#undef SEAM
#undef RELANE
}

extern "C" void kernel_launch(void* const* d_in, const int* in_sizes, int n_in, void* d_out, int out_size, void* d_ws, size_t ws_size, hipStream_t stream) {
    static int grid = 0;
    if (grid == 0) {
        if (n_in != 23 || in_sizes[0] != T * D || out_size != T * D || ws_size < WS_END) { fprintf(stderr, "kernel_launch: unexpected shapes (n_in %d, in0 %d, out %d, ws %zu)\n", n_in, n_in > 0 ? in_sizes[0] : -1, out_size, ws_size); grid = -1; return; }
        int dev = 0, cus = 0, per_cu = 0;
        if (hipGetDevice(&dev) != hipSuccess || hipDeviceGetAttribute(&cus, hipDeviceAttributeMultiprocessorCount, dev) != hipSuccess) { grid = -1; return; }
        if (hipFuncSetAttribute((const void*)fwd_kernel, hipFuncAttributeMaxDynamicSharedMemorySize, LDS_BYTES) != hipSuccess) { fprintf(stderr, "kernel_launch: hipFuncSetAttribute failed\n"); grid = -1; return; }
        if (hipOccupancyMaxActiveBlocksPerMultiprocessor(&per_cu, (const void*)fwd_kernel, NTHREADS, LDS_BYTES) != hipSuccess || per_cu < 1) fprintf(stderr, "kernel_launch: occupancy query says %d\n", per_cu);
        (void)hipGetLastError();
        if (cus != 256) { fprintf(stderr, "kernel_launch: built for 256 CUs, found %d\n", cus); grid = -1; return; }
        grid = cus;
    }
    if (grid < 0) return;
    if (hipMemsetAsync((char*)d_ws + WS_CTL, 0, CTL_ZERO_BYTES, stream) != hipSuccess) return;
    Args a{};
    for (int i = 0; i < 23; ++i) a.in[i] = (const float*)d_in[i];
    a.out = (float*)d_out; a.ws = (unsigned char*)d_ws; a.pad = 0;
#if MK_PER_PHASE
    for (int p = 0; p < NPHASES; ++p) { a.ph_lo = p; a.ph_hi = p + 1; a.li = 0; hipLaunchKernelGGL(fwd_kernel, dim3(grid), dim3(NTHREADS), LDS_BYTES, stream, a); }
#else
    a.ph_lo = 0; a.ph_hi = NPHASES; a.li = 0;
    hipLaunchKernelGGL(fwd_kernel, dim3(grid), dim3(NTHREADS), LDS_BYTES, stream, a);
#endif
}
```

```cpp
#define MK_PER_PHASE 0
#include <hip/hip_runtime.h>
#include <cstdio>
#include <cstdint>
#include <cmath>
namespace pg8 {
#define PG8_LAS __attribute__((address_space(3)))
typedef unsigned short bf16_t;
typedef short bf16x8 __attribute__((ext_vector_type(8)));
typedef float f32x4 __attribute__((ext_vector_type(4)));
typedef unsigned u32x4 __attribute__((ext_vector_type(4)));
typedef int i32x4 __attribute__((ext_vector_type(4)));
typedef int i32x8 __attribute__((ext_vector_type(8)));
constexpr int BM = 256, BK = 64, HALF = 128, HTB = HALF * BK * 2  , STAGE_BYTES = 8 * HTB, NXCD = 8, WGM = 8;

__host__ __device__ __forceinline__ int lds_byte(int r, int c) { const int st = (r >> 4) * 2 + (c >> 5), rr = r & 15, cc = c & 31, ob = rr * 64 + cc * 2; return st * 1024 + (ob ^ (((ob >> 9) & 1) << 5)); }
__host__ __device__ __forceinline__ void stage_rc(int b, int& R, int& C) { const int st = b / 1024, sb = b % 1024, swz = sb ^ (((sb >> 9) & 1) << 5); R = (st >> 1) * 16 + swz / 64; C = (st & 1) * 32 + (swz % 64) / 2; }
__host__ __device__ __forceinline__ int perm32(int rho) { const int n = rho >> 4, i = rho & 15; return 8 * (i >> 2) + 4 * n + (i & 3); }

struct Unit { int pm, pn, pc; };
struct Gemm { const bf16_t* A; const bf16_t* Bt; int M, N, K; };

struct StaticOrder {
    int nM, nN, nwg, G, c;
    __host__ __device__ void init(int M, int N, int G_, int c_) { nM = M / BM; nN = N / BM; nwg = nM * nN; G = G_; c = c_; }
    __host__ __device__ bool next(int i, Unit& u) const {
        const long L = (long)i * G + c; if (L >= nwg) return false;
        int wgid = (int)L; { const int q = nwg / NXCD, r = nwg % NXCD, xcd = wgid % NXCD, off = wgid / NXCD; wgid = (xcd < r ? xcd * (q + 1) : r * (q + 1) + (xcd - r) * q) + off; }
        const int nig = WGM * nN, gid = wgid / nig, fm = gid * WGM, gsz = (nM - fm) < WGM ? (nM - fm) : WGM;
        u.pm = fm + ((wgid % nig) % gsz); u.pn = (wgid % nig) / gsz; u.pc = u.pn; return true;
    }
    __device__ __forceinline__ void a_ready(const Unit&) const {}
    __device__ __forceinline__ void done(const Unit&) const {}
};

__device__ __forceinline__ unsigned cvt_pk_bf16(float lo, float hi) { unsigned r; asm volatile("v_cvt_pk_bf16_f32 %0, %1, %2" : "=v"(r) : "v"(lo), "v"(hi)); return r; }
typedef float f32x2 __attribute__((ext_vector_type(2)));
__device__ __forceinline__ float silu_f(float x) { return x * __builtin_amdgcn_rcpf(1.0f + __expf(-x)); }
struct EpiStoreBf16 {
    static constexpr bool PERM = true, AFTER_DRAIN = false;
    bf16_t* O; int ldc;
    __device__ __forceinline__ void operator()(const f32x4 (&acc)[2][2][4][2], const Unit& u, int wr, int wc, int fr, int fq) const {
        const int row0 = u.pm * BM + wr * 64 + fr, col0 = u.pc * BM + wc * 32 + 8 * fq;
#pragma unroll
        for (int ai = 0; ai < 2; ++ai)
#pragma unroll
            for (int m = 0; m < 4; ++m) { bf16_t* rowp = O + (size_t)(row0 + ai * HALF + m * 16) * ldc + col0;
#pragma unroll
                for (int bj = 0; bj < 2; ++bj) { const f32x4 v0 = acc[ai][bj][m][0], v1 = acc[ai][bj][m][1];
                    u32x4 w; w.x = cvt_pk_bf16(v0[0], v0[1]); w.y = cvt_pk_bf16(v0[2], v0[3]); w.z = cvt_pk_bf16(v1[0], v1[1]); w.w = cvt_pk_bf16(v1[2], v1[3]);
                    *(u32x4*)(rowp + bj * HALF) = w; } }
    }
};
struct EpiStoreTiled {
    static constexpr bool PERM = true, AFTER_DRAIN = false;
    bf16_t* O; int nrt; float scale = 1.0f;
    __device__ __forceinline__ void operator()(const f32x4 (&acc)[2][2][4][2], const Unit& u, int wr, int wc, int fr, int fq) const {
        const int row0 = u.pm * BM + wr * 64 + fr, col0 = u.pc * BM + wc * 32 + 8 * fq;
#pragma unroll
        for (int ai = 0; ai < 2; ++ai)
#pragma unroll
            for (int m = 0; m < 4; ++m) { const int row = row0 + ai * HALF + m * 16;
#pragma unroll
                for (int bj = 0; bj < 2; ++bj) { const int col = col0 + bj * HALF; const f32x4 v0 = acc[ai][bj][m][0] * scale, v1 = acc[ai][bj][m][1] * scale;
                    u32x4 w; w.x = cvt_pk_bf16(v0[0], v0[1]); w.y = cvt_pk_bf16(v0[2], v0[3]); w.z = cvt_pk_bf16(v1[0], v1[1]); w.w = cvt_pk_bf16(v1[2], v1[3]);
                    *(u32x4*)(O + ((size_t)(col >> 4) * nrt + (row >> 5)) * 512 + ((row & 31) + 32 * ((col >> 3) & 1)) * 8) = w; } }
    }
};
template <bool BF32> struct EpiResidH {
    static constexpr bool PERM = true, AFTER_DRAIN = false;
    const void* base; bf16_t* out; int ldc; float scale;
    __device__ __forceinline__ void operator()(const f32x4 (&acc)[2][2][4][2], const Unit& u, int wr, int wc, int fr, int fq) const {
        const int row0 = u.pm * BM + wr * 64 + fr, col0 = u.pc * BM + wc * 32 + 8 * fq;
#pragma unroll
        for (int ai = 0; ai < 2; ++ai)
#pragma unroll
            for (int m = 0; m < 4; ++m) { const size_t off = (size_t)(row0 + ai * HALF + m * 16) * ldc + col0;
#pragma unroll
                for (int bj = 0; bj < 2; ++bj) { f32x4 v0 = acc[ai][bj][m][0] * scale, v1 = acc[ai][bj][m][1] * scale;
                    if constexpr (BF32) { const float* bp = (const float*)base + off + bj * HALF; v0 += *(const f32x4*)bp; v1 += *(const f32x4*)(bp + 4); }
                    else { const u32x4 b = __builtin_nontemporal_load((const u32x4*)((const bf16_t*)base + off + bj * HALF));
                        v0[0] += __builtin_bit_cast(float, b.x << 16); v0[1] += __builtin_bit_cast(float, b.x & 0xffff0000u); v0[2] += __builtin_bit_cast(float, b.y << 16); v0[3] += __builtin_bit_cast(float, b.y & 0xffff0000u);
                        v1[0] += __builtin_bit_cast(float, b.z << 16); v1[1] += __builtin_bit_cast(float, b.z & 0xffff0000u); v1[2] += __builtin_bit_cast(float, b.w << 16); v1[3] += __builtin_bit_cast(float, b.w & 0xffff0000u); }
                    u32x4 w; w.x = cvt_pk_bf16(v0[0], v0[1]); w.y = cvt_pk_bf16(v0[2], v0[3]); w.z = cvt_pk_bf16(v1[0], v1[1]); w.w = cvt_pk_bf16(v1[2], v1[3]);
                    *(u32x4*)(out + off + bj * HALF) = w; } }
    }
};
struct EpiSwiGLU {
    static constexpr bool PERM = true, AFTER_DRAIN = false;
    bf16_t* O; int ldc;
    __device__ __forceinline__ void pk4(const f32x4 g, const f32x4 u, unsigned& lo, unsigned& hi) const {
        const f32x4 t = g * (-1.4426950408889634f), gu = g * u; float r[4];
#pragma unroll
        for (int i = 0; i < 4; ++i) r[i] = gu[i] * __builtin_amdgcn_rcpf(1.0f + __builtin_amdgcn_exp2f(t[i]));
        lo = cvt_pk_bf16(r[0], r[1]); hi = cvt_pk_bf16(r[2], r[3]);
    }
    __device__ __forceinline__ void operator()(const f32x4 (&acc)[2][2][4][2], const Unit& u, int wr, int wc, int fr, int fq) const {
        const int row0 = u.pm * BM + wr * 64 + fr, col0 = u.pc * HALF + wc * 32 + 8 * fq;
#pragma unroll
        for (int ai = 0; ai < 2; ++ai)
#pragma unroll
            for (int m = 0; m < 4; ++m) { bf16_t* rowp = O + (size_t)(row0 + ai * HALF + m * 16) * ldc + col0;
                unsigned w0, w1, w2, w3; pk4(acc[ai][0][m][0], acc[ai][1][m][0], w0, w1); pk4(acc[ai][0][m][1], acc[ai][1][m][1], w2, w3);
                *(u32x4*)rowp = (u32x4){w0, w1, w2, w3}; }
    }
};
__device__ __forceinline__ unsigned pk4_f8(float a, float b, float c, float d) {
    a = fminf(fmaxf(a, -448.f), 448.f); b = fminf(fmaxf(b, -448.f), 448.f); c = fminf(fmaxf(c, -448.f), 448.f); d = fminf(fmaxf(d, -448.f), 448.f);
    int w = __builtin_amdgcn_cvt_pk_fp8_f32(a, b, 0, false); w = __builtin_amdgcn_cvt_pk_fp8_f32(c, d, w, true); return (unsigned)w;
}
struct EpiSwiGLUF8 {
    static constexpr bool PERM = true, AFTER_DRAIN = false;
    unsigned char* O; int ldc; float inv, osc;
    __device__ __forceinline__ unsigned pk4(const f32x4 g, const f32x4 u, float c1, float c2) const {
        const f32x4 t = g * c1, gu = (g * u) * c2; float r[4];
#pragma unroll
        for (int i = 0; i < 4; ++i) { const float s = __builtin_amdgcn_rcpf(1.0f + __builtin_amdgcn_exp2f(t[i])); r[i] = __builtin_amdgcn_fmed3f(gu[i] * s, -448.f, 448.f); }
        int w = __builtin_amdgcn_cvt_pk_fp8_f32(r[0], r[1], 0, false); w = __builtin_amdgcn_cvt_pk_fp8_f32(r[2], r[3], w, true); return (unsigned)w;
    }
    __device__ __forceinline__ void operator()(const f32x4 (&acc)[2][2][4][2], const Unit& u, int wr, int wc, int fr, int fq) const {
        const int row0 = u.pm * BM + wr * 64 + fr, col0 = u.pc * HALF + wc * 32 + 8 * fq;
        const float c1 = -inv * 1.4426950408889634f, c2 = inv * inv * osc;
#pragma unroll
        for (int ai = 0; ai < 2; ++ai)
#pragma unroll
            for (int m = 0; m < 4; ++m) { unsigned char* rowp = O + (size_t)(row0 + ai * HALF + m * 16) * ldc + col0;
                typedef unsigned u32x2 __attribute__((ext_vector_type(2))); u32x2 w;
                w.x = pk4(acc[ai][0][m][0], acc[ai][1][m][0], c1, c2); w.y = pk4(acc[ai][0][m][1], acc[ai][1][m][1], c1, c2);
                *(u32x2*)rowp = w; }
    }
};
struct EpiStoreBf16S {
    static constexpr bool PERM = true, AFTER_DRAIN = false;
    bf16_t* O; int ldc; float scale;
    __device__ __forceinline__ void operator()(const f32x4 (&acc)[2][2][4][2], const Unit& u, int wr, int wc, int fr, int fq) const {
        const int row0 = u.pm * BM + wr * 64 + fr, col0 = u.pc * BM + wc * 32 + 8 * fq;
#pragma unroll
        for (int ai = 0; ai < 2; ++ai)
#pragma unroll
            for (int m = 0; m < 4; ++m) { bf16_t* rowp = O + (size_t)(row0 + ai * HALF + m * 16) * ldc + col0;
#pragma unroll
                for (int bj = 0; bj < 2; ++bj) { const f32x4 v0 = acc[ai][bj][m][0] * scale, v1 = acc[ai][bj][m][1] * scale;
                    u32x4 w; w.x = cvt_pk_bf16(v0[0], v0[1]); w.y = cvt_pk_bf16(v0[2], v0[3]); w.z = cvt_pk_bf16(v1[0], v1[1]); w.w = cvt_pk_bf16(v1[2], v1[3]);
                    *(u32x4*)(rowp + bj * HALF) = w; } }
    }
};
struct MoeOrder {
    int ntl, ncol, G, c, tile0; const PG8_LAS int* texp;
    __device__ __forceinline__ bool next(int i, Unit& u) const {
        const int nwg = ntl * ncol; int wgid = i * G + c; if (wgid >= nwg) return false;
        { const int q = nwg / NXCD, rr = nwg % NXCD, xcd = wgid % NXCD, off = wgid / NXCD; wgid = (xcd < rr ? xcd * (q + 1) : rr * (q + 1) + (xcd - rr) * q) + off; }
        const int nig = WGM * ncol, gid = wgid / nig, fm = gid * WGM, gsz = (ntl - fm) < WGM ? (ntl - fm) : WGM;
        const int pm = fm + ((wgid % nig) % gsz), pc = (wgid % nig) / gsz; const int e = __builtin_amdgcn_readfirstlane(texp[tile0 + pm]);
        u.pm = pm; u.pc = pc; u.pn = e * ncol + pc; return true;
    }
    __device__ __forceinline__ void a_ready(const Unit&) const {}
    __device__ __forceinline__ void done(const Unit&) const {}
};
template <unsigned long long LUT, int NN> struct LutOrder {
    int nM, nwg, G, c;
    __host__ __device__ void init(int M, int G_, int c_) { nM = M / BM; nwg = nM * NN; G = G_; c = c_; }
    __device__ __forceinline__ bool next(int i, Unit& u) const {
        const long L = (long)i * G + c; if (L >= nwg) return false;
        int wgid = (int)L; { const int q = nwg / NXCD, r = nwg % NXCD, xcd = wgid % NXCD, off = wgid / NXCD; wgid = (xcd < r ? xcd * (q + 1) : r * (q + 1) + (xcd - r) * q) + off; }
        const int nig = WGM * NN, gid = wgid / nig, fm = gid * WGM, gsz = (nM - fm) < WGM ? (nM - fm) : WGM;
        u.pm = fm + ((wgid % nig) % gsz); const int pn = (wgid % nig) / gsz; u.pn = (int)((LUT >> (4 * pn)) & 15ull); u.pc = u.pn; return true;
    }
    __device__ __forceinline__ void a_ready(const Unit&) const {}
    __device__ __forceinline__ void done(const Unit&) const {}
};
template <bool ML> struct EpiStoreVT {
    static constexpr bool PERM = false, AFTER_DRAIN = false;
    bf16_t* O; float scale;
    __device__ __forceinline__ void operator()(const f32x4 (&acc)[2][2][4][2], const Unit& u, int wr, int wc, int fr, int fq) const {
        const int pcv = ML ? u.pc - 4 : (u.pc < 6 ? u.pc - 4 : u.pc - 8);
        const int tb = u.pm * BM + wr * 64 + 8 * fq;
#pragma unroll
        for (int ai = 0; ai < 2; ++ai)
#pragma unroll
            for (int bj = 0; bj < 2; ++bj) { const int cb5 = pcv * 8 + bj * 4 + wc;
#pragma unroll
                for (int k = 0; k < 2; ++k) { const int t = tb + ai * HALF + 32 * k, b = t >> 12, tk = (t & 4095) >> 4;
                    const int idx = ML ? (b * 4 + (cb5 >> 3)) * 9 + (cb5 & 7) : b * 32 + cb5;
                    bf16_t* blk = O + ((size_t)idx * 256 + tk) * 512 + (32 * (fq & 1) + fr) * 8;
#pragma unroll
                    for (int n = 0; n < 2; ++n) { const f32x4 v0 = acc[ai][bj][2 * k][n] * scale, v1 = acc[ai][bj][2 * k + 1][n] * scale;
                        u32x4 w; w.x = cvt_pk_bf16(v0[0], v0[1]); w.y = cvt_pk_bf16(v0[2], v0[3]); w.z = cvt_pk_bf16(v1[0], v1[1]); w.w = cvt_pk_bf16(v1[2], v1[3]);
                        *(u32x4*)(blk + n * 128) = w; } } }
    }
};
template <class Epi, class Sched, bool ALIGN_EPI = false, bool SP2 = false, bool F8 = false, bool SWAP = false>
__device__ __forceinline__ void gemm_phase(PG8_LAS unsigned char* lds, const Gemm g, const Sched& S, const Epi& E) {
    int tid_ = threadIdx.x; asm volatile("" : "+v"(tid_));
    const int tid = tid_, wid = __builtin_amdgcn_readfirstlane(tid >> 6), lane = tid & 63, wr = wid >> 2, wc = wid & 3, fr = lane & 15, fq = lane >> 4;
    const int K = g.K, nt = K / BK;
    unsigned voffA[2], voffB[2];
#pragma unroll
    for (int i = 0; i < 2; ++i) { int R, C; stage_rc(tid * 16 + i * 8192, R, C); const int Rp = (R & ~31) + perm32(R & 31), Ra = SWAP ? Rp : R, Rb = (!SWAP && Epi::PERM) ? Rp : R;
        voffA[i] = (unsigned)(Ra * K + C) * 2u; voffB[i] = (unsigned)(Rb * K + C) * 2u; }
    const size_t kstep = (size_t)(BK * 2);
    const size_t hstep = (size_t)HALF * K * 2;
    const size_t tstep = 2 * hstep;
    const unsigned ldsw = (unsigned)wid * 1024u;
    const int aoff = lds_byte(wr * 64 + fr, fq * 8), boff = lds_byte(wc * 32 + fr, fq * 8);
#define PG8_SA(b, h) (((b) * 2 + (h)) * HTB)
#define PG8_SB(b, h) ((4 + (b) * 2 + (h)) * HTB)
#define PG8_STAGE(bufoff, gbase, voff) do { _Pragma("unroll") for (int _i = 0; _i < 2; ++_i) \
        __builtin_amdgcn_global_load_lds((const unsigned*)((const char*)(gbase) + (voff)[_i]), (PG8_LAS unsigned*)(lds + (bufoff) + ldsw + _i * 8192), 16, 0, 0); } while (0)
#define PG8_LD16(off) (*(const PG8_LAS i32x4*)(lds + (off)))
#define PG8_LDA(dst, b, h) do { _Pragma("unroll") for (int m = 0; m < 4; ++m) dst[m] = PG8_CAT8(PG8_LD16(PG8_SA(b, h) + aoff + m * 2048), PG8_LD16(PG8_SA(b, h) + aoff + m * 2048 + 1024)); } while (0)
#define PG8_LDB(dst, b, h) do { _Pragma("unroll") for (int n = 0; n < 2; ++n) dst[n] = PG8_CAT8(PG8_LD16(PG8_SB(b, h) + boff + n * 2048), PG8_LD16(PG8_SB(b, h) + boff + n * 2048 + 1024)); } while (0)
#define PG8_CAT8(x, y) __builtin_shufflevector((x), (y), 0, 1, 2, 3, 4, 5, 6, 7)
#define PG8_HALF(v, k) __builtin_bit_cast(bf16x8, __builtin_shufflevector((v), (v), 4 * (k), 4 * (k) + 1, 4 * (k) + 2, 4 * (k) + 3))
#define PG8_MMA(ai, bj, At, Bt) do { __builtin_amdgcn_s_setprio(1); _Pragma("unroll") for (int m = 0; m < 4; ++m) _Pragma("unroll") for (int n = 0; n < 2; ++n) { \
        if constexpr (F8 && SWAP) asm volatile("v_mfma_scale_f32_16x16x128_f8f6f4 %0, %1, %2, %0, %3, %3 op_sel_hi:[0,0,0]" : "+v"(acc[ai][bj][m][n]) : "v"(At[m]), "v"(Bt[n]), "v"(f8one)); \
        else if constexpr (F8) asm volatile("v_mfma_scale_f32_16x16x128_f8f6f4 %0, %1, %2, %0, %3, %3 op_sel_hi:[0,0,0]" : "+v"(acc[ai][bj][m][n]) : "v"(Bt[n]), "v"(At[m]), "v"(f8one));   \
        else if constexpr (SWAP) { acc[ai][bj][m][n] = __builtin_amdgcn_mfma_f32_16x16x32_bf16(PG8_HALF(At[m], 0), PG8_HALF(Bt[n], 0), acc[ai][bj][m][n], 0, 0, 0); \
               acc[ai][bj][m][n] = __builtin_amdgcn_mfma_f32_16x16x32_bf16(PG8_HALF(At[m], 1), PG8_HALF(Bt[n], 1), acc[ai][bj][m][n], 0, 0, 0); } \
        else { acc[ai][bj][m][n] = __builtin_amdgcn_mfma_f32_16x16x32_bf16(PG8_HALF(Bt[n], 0), PG8_HALF(At[m], 0), acc[ai][bj][m][n], 0, 0, 0); \
               acc[ai][bj][m][n] = __builtin_amdgcn_mfma_f32_16x16x32_bf16(PG8_HALF(Bt[n], 1), PG8_HALF(At[m], 1), acc[ai][bj][m][n], 0, 0, 0); } } \
        __builtin_amdgcn_s_setprio(0); } while (0)
#define PG8_WAIT_V(n) asm volatile("s_waitcnt vmcnt(" #n ")" ::: "memory")
#define PG8_WAIT_L(n) asm volatile("s_waitcnt lgkmcnt(" #n ")" ::: "memory")
#define PG8_BAR __builtin_amdgcn_s_barrier()
#define PG8_SCHED __builtin_amdgcn_sched_barrier(0)
    Unit cur, nxt; int ui = 0;
    if (!S.next(0, cur)) return;
    f32x4 acc[2][2][4][2];
#pragma unroll
    for (int a = 0; a < 2; ++a)
#pragma unroll
        for (int b = 0; b < 2; ++b)
#pragma unroll
            for (int m = 0; m < 4; ++m)
#pragma unroll
                for (int n = 0; n < 2; ++n) acc[a][b][m][n] = (f32x4){0.f, 0.f, 0.f, 0.f};
    const int f8one = 0x7f7f7f7f;
    i32x8 At[4], B0[2], B1[2];
    const char* cA = (const char*)g.A + (size_t)cur.pm * tstep; const char* cB = (const char*)g.Bt + (size_t)cur.pn * tstep;
    S.a_ready(cur);
    if constexpr (SP2) {
        PG8_STAGE(PG8_SB(0, 0), cB, voffB); PG8_STAGE(PG8_SB(0, 1), cB + hstep, voffB); PG8_STAGE(PG8_SA(0, 0), cA, voffA); PG8_STAGE(PG8_SA(0, 1), cA + hstep, voffA);
        if (wr == 1) PG8_BAR;
        PG8_WAIT_V(2); PG8_BAR;
        PG8_STAGE(PG8_SB(1, 0), cB + kstep, voffB); PG8_STAGE(PG8_SA(1, 0), cA + kstep, voffA); PG8_STAGE(PG8_SB(1, 1), cB + hstep + kstep, voffB);
        PG8_WAIT_V(6); PG8_BAR;
    } else {
        PG8_STAGE(PG8_SB(0, 0), cB, voffB); PG8_STAGE(PG8_SA(0, 0), cA, voffA); PG8_STAGE(PG8_SB(0, 1), cB + hstep, voffB); PG8_STAGE(PG8_SA(0, 1), cA + hstep, voffA);
        if (wr == 1) PG8_BAR;
        PG8_WAIT_V(4); PG8_BAR;
        PG8_STAGE(PG8_SB(1, 0), cB + kstep, voffB); PG8_STAGE(PG8_SA(1, 0), cA + kstep, voffA); PG8_STAGE(PG8_SB(1, 1), cB + hstep + kstep, voffB);
        PG8_WAIT_V(6); PG8_BAR;
    }
    for (;;) {
        const bool has_next = S.next(ui + 1, nxt);
        const char* nA = has_next ? (const char*)g.A + (size_t)nxt.pm * tstep : cA; const char* nB = has_next ? (const char*)g.Bt + (size_t)nxt.pn * tstep : cB;
        for (int t = 0; t < nt; t += 2) {
            const bool last = (t == nt - 2);
            const char* a1 = cA + (size_t)(t + 1) * kstep;
            const char* a2 = last ? nA : cA + (size_t)(t + 2) * kstep; const char* b2 = last ? nB : cB + (size_t)(t + 2) * kstep;
            const char* a3 = a2 + kstep; const char* b3 = b2 + kstep;
            if (last && has_next) S.a_ready(nxt);
            if constexpr (SP2) {
            PG8_LDB(B0, 0, 0); PG8_LDB(B1, 0, 1); PG8_SCHED; PG8_LDA(At, 0, 0); PG8_STAGE(PG8_SA(1, 1), a1 + hstep, voffA);
            PG8_WAIT_V(8); PG8_WAIT_L(0); PG8_BAR; PG8_MMA(0, 0, At, B0); PG8_MMA(0, 1, At, B1); PG8_BAR; PG8_SCHED;
            PG8_LDA(At, 0, 1); PG8_STAGE(PG8_SB(0, 0), b2, voffB); PG8_STAGE(PG8_SB(0, 1), b2 + hstep, voffB); PG8_STAGE(PG8_SA(0, 0), a2, voffA);
            PG8_WAIT_V(8); PG8_WAIT_L(0); PG8_BAR; PG8_MMA(1, 0, At, B0); PG8_MMA(1, 1, At, B1); PG8_BAR; PG8_SCHED;
            PG8_LDB(B0, 1, 0); PG8_LDB(B1, 1, 1); PG8_SCHED; PG8_LDA(At, 1, 0); PG8_STAGE(PG8_SA(0, 1), a2 + hstep, voffA);
            PG8_WAIT_V(8); PG8_WAIT_L(0); PG8_BAR; PG8_MMA(0, 0, At, B0); PG8_MMA(0, 1, At, B1); PG8_BAR; PG8_SCHED;
            PG8_LDA(At, 1, 1); PG8_STAGE(PG8_SB(1, 0), b3, voffB); PG8_STAGE(PG8_SB(1, 1), b3 + hstep, voffB); PG8_STAGE(PG8_SA(1, 0), a3, voffA);
            PG8_WAIT_V(8); PG8_WAIT_L(0); PG8_BAR; PG8_MMA(1, 0, At, B0); PG8_MMA(1, 1, At, B1); PG8_BAR; PG8_SCHED;
            } else {
            PG8_LDB(B0, 0, 0); PG8_SCHED; PG8_LDA(At, 0, 0); PG8_STAGE(PG8_SA(1, 1), a1 + hstep, voffA);
            PG8_WAIT_L(8); PG8_BAR; PG8_WAIT_L(0); PG8_MMA(0, 0, At, B0); PG8_BAR; PG8_SCHED;
            PG8_LDB(B1, 0, 1); PG8_STAGE(PG8_SB(0, 0), b2, voffB);
            PG8_BAR; PG8_WAIT_L(0); PG8_MMA(0, 1, At, B1); PG8_BAR;
            PG8_LDA(At, 0, 1); PG8_STAGE(PG8_SA(0, 0), a2, voffA);
            PG8_BAR; PG8_WAIT_L(0); PG8_MMA(1, 0, At, B0); PG8_BAR; PG8_SCHED;
            PG8_STAGE(PG8_SB(0, 1), b2 + hstep, voffB);
            PG8_WAIT_V(6); PG8_BAR; PG8_MMA(1, 1, At, B1); PG8_BAR;
            PG8_LDB(B0, 1, 0); PG8_SCHED; PG8_LDA(At, 1, 0); PG8_STAGE(PG8_SA(0, 1), a2 + hstep, voffA);
            PG8_WAIT_L(8); PG8_BAR; PG8_WAIT_L(0); PG8_MMA(0, 0, At, B0); PG8_BAR; PG8_SCHED;
            PG8_LDB(B1, 1, 1); PG8_STAGE(PG8_SB(1, 0), b3, voffB);
            PG8_BAR; PG8_WAIT_L(0); PG8_MMA(0, 1, At, B1); PG8_BAR;
            PG8_LDA(At, 1, 1); PG8_STAGE(PG8_SA(1, 0), a3, voffA);
            PG8_BAR; PG8_WAIT_L(0); PG8_MMA(1, 0, At, B0); PG8_BAR; PG8_SCHED;
            PG8_STAGE(PG8_SB(1, 1), b3 + hstep, voffB);
            PG8_WAIT_V(6); PG8_BAR; PG8_MMA(1, 1, At, B1); PG8_BAR;
            }
        }
        if constexpr (ALIGN_EPI) { if (wr == 0) PG8_BAR; }
        if constexpr (!Epi::AFTER_DRAIN) { E(acc, cur, wr, wc, fr, fq); S.done(cur); }
        if (!has_next) break;
#pragma unroll
        for (int a = 0; a < 2; ++a)
#pragma unroll
            for (int b = 0; b < 2; ++b)
#pragma unroll
                for (int m = 0; m < 4; ++m)
#pragma unroll
                    for (int n = 0; n < 2; ++n) acc[a][b][m][n] = (f32x4){0.f, 0.f, 0.f, 0.f};
        cur = nxt; cA = nA; cB = nB; ++ui;
        if constexpr (ALIGN_EPI) { if (wr == 1) PG8_BAR; }
    }
    PG8_WAIT_V(0);
    if constexpr (!ALIGN_EPI) { if (wr == 0) PG8_BAR; }
    PG8_BAR;
    if constexpr (Epi::AFTER_DRAIN) { E.fused(acc, cur, wr, wc, fr, fq, lds, wid, lane); S.done(cur); }
#undef PG8_SA
#undef PG8_SB
#undef PG8_STAGE
#undef PG8_LDA
#undef PG8_LDB
#undef PG8_MMA
#undef PG8_CAT8
#undef PG8_HALF
#undef PG8_LD16
#undef PG8_WAIT_V
#undef PG8_WAIT_L
#undef PG8_BAR
#undef PG8_SCHED
}
}

constexpr int NWAVES = 8, NTHREADS = NWAVES * 64;
constexpr int T = 32768, D = 1024, SEQ = 4096, NBATCH = 8;
constexpr int NQKV = 3072, DFF = 2816, DFFE = 3584, NEXP = 8, MLW = 3080;
constexpr float EPS = 1e-6f;
#ifndef LATE_QKV
#define LATE_QKV 1
#endif
#ifndef LATE_INP
#define LATE_INP 1
#endif
#ifndef LATE_OUT
#define LATE_OUT 0
#endif
#ifndef LATE_F8
#define LATE_F8 1
#endif
#ifndef DENSE_F8_L2
#define DENSE_F8_L2 1
#endif
constexpr float W_GU_SCALE = 64.f, W_D_SCALE = 128.f, X_SCALE = 4.f, ACT_SCALE = 4.f;
constexpr int NPH_PAIR = 18, NPHASES = 2 * NPH_PAIR + 1;
#ifndef MK_PER_PHASE
#define MK_PER_PHASE 0
#endif

constexpr size_t MiB = 1u << 20;
constexpr size_t WS_CTL = 0, CTL_ZERO_BYTES = MK_PER_PHASE ? 1 * MiB : 64 * 1024;
constexpr size_t WS_TOKE = 1 * MiB;
constexpr size_t WS_TOKW = WS_TOKE + 256 * 1024;
constexpr size_t WS_TOKP = WS_TOKW + 256 * 1024;
constexpr size_t WS_WGCNT = WS_TOKP + 256 * 1024;
constexpr size_t WS_EOFF = WS_WGCNT + 16 * 1024;
constexpr size_t WS_GATES = 2 * MiB;
constexpr size_t WS_TA = 3 * MiB, WS_TU = WS_TA + 512 * 1024, WS_TM = WS_TU + 512 * 1024, WS_CP = WS_TM + 512 * 1024, WS_CG = WS_CP + 64 * 1024;
constexpr size_t WS_W = 8 * MiB;
constexpr size_t WS_WQKV = WS_W, WS_WO = WS_W + 6 * MiB, WS_WGU = WS_W + 8 * MiB, WS_WD = WS_W + 19 * MiB;
constexpr size_t WS_WIN = WS_W, WS_WEGU = WS_W + 8 * MiB, WS_WED = WS_W + 64 * MiB;
constexpr size_t WS_XN = 184 * MiB;
constexpr size_t WS_R = 248 * MiB;
constexpr size_t WS_U = WS_R;
constexpr size_t WS_O = WS_R + 192 * MiB;
constexpr size_t WS_VTA = WS_R + 256 * MiB;
constexpr size_t WS_ACT = WS_R;
constexpr size_t WS_QF = WS_R + 192 * MiB, WS_KF = WS_R + 224 * MiB;
constexpr size_t WS_KT = WS_R + 256 * MiB;
constexpr size_t WS_VT = WS_R + 288 * MiB;
constexpr size_t WS_CTS = WS_R + 360 * MiB;
constexpr size_t WS_HM = WS_R + 504 * MiB;
constexpr size_t WS_XG = WS_R;
constexpr size_t WS_Y = WS_R + 66 * MiB;
constexpr size_t WS_ACTM = WS_R + 198 * MiB;
constexpr size_t WS_HB = 832 * MiB;
constexpr size_t WS_END = 896 * MiB;
constexpr int CW_BAR = 4096;

constexpr int RING_BYTES = 131072;
constexpr int LDSCTL_OFF = RING_BYTES;
constexpr int L_TEXP = LDSCTL_OFF;
constexpr int L_MISC = LDSCTL_OFF + 2048;
constexpr int L_CNT = LDSCTL_OFF + 2304;
constexpr int L_PTR = LDSCTL_OFF + 2560;
constexpr int L_SCR = LDSCTL_OFF + 4096;
constexpr int LDS_BYTES = 147456;

#define GAS __attribute__((address_space(1)))
#define LAS __attribute__((address_space(3)))
typedef unsigned short bf16;
typedef unsigned v4u __attribute__((ext_vector_type(4)));
typedef unsigned v2u __attribute__((ext_vector_type(2)));
typedef float f32x4 __attribute__((ext_vector_type(4)));
typedef GAS unsigned gu32;
#define RLX_AGENT __ATOMIC_RELAXED, __HIP_MEMORY_SCOPE_AGENT
#define LDS_WAIT() asm volatile("s_waitcnt lgkmcnt(0)" ::: "memory")
#define VM_WAIT() asm volatile("s_waitcnt vmcnt(0)" ::: "memory")
__device__ __forceinline__ unsigned f2bf(float f) { unsigned u = __builtin_bit_cast(unsigned, f); return (u + 0x7fffu + ((u >> 16) & 1u)) >> 16; }
__device__ __forceinline__ unsigned pk2(float lo, float hi) { return f2bf(lo) | (f2bf(hi) << 16); }
__device__ __forceinline__ float bflo(unsigned w) { return __builtin_bit_cast(float, w << 16); }
__device__ __forceinline__ float bfhi(unsigned w) { return __builtin_bit_cast(float, w & 0xffff0000u); }
__device__ __forceinline__ int ld_i32(const int* p) { return (int)__hip_atomic_load((const unsigned*)p, RLX_AGENT); }

#define XB_TMO      128
#define XB_XCNT(j)  (256  + 64 * (j))
#define XB_XSUB(j)  (1280 + 64 * (j))
#define XB_XGEN(j)  (2304 + 64 * (j))
#define XB_TOP      3328
#define XB_TOPGEN   3392
#define XCD_BAR_WORDS 3456
#define XB_SPIN_CAP (1u << 18)

__device__ __forceinline__ unsigned xb_ld(unsigned* p)              { return __hip_atomic_load(p, __ATOMIC_RELAXED, __HIP_MEMORY_SCOPE_AGENT); }
__device__ __forceinline__ unsigned xb_add(unsigned* p, unsigned v) { return __hip_atomic_fetch_add(p, v, __ATOMIC_RELAXED, __HIP_MEMORY_SCOPE_AGENT); }
__device__ __forceinline__ unsigned xb_xcc_id() { return (unsigned)__builtin_amdgcn_s_getreg((3 << 11) | 20) & 0xFu; }
#define XB_SPIN(cond, bar) do { unsigned _sp = 0; while (cond) { __builtin_amdgcn_s_sleep(1); \
    if ((++_sp & 255u) == 0u) { if (xb_ld(&(bar)[XB_TMO])) break; if (_sp > XB_SPIN_CAP) { atomicAdd(&(bar)[XB_TMO], 1u); break; } } } } while (0)

struct XcdBarrier {
    unsigned* bar; unsigned x;
    volatile LAS unsigned* st;
};

__device__ __forceinline__ XcdBarrier xcd_barrier_post(unsigned* bar, volatile LAS unsigned* st) {
    XcdBarrier b; b.bar = bar; b.x = xb_xcc_id(); b.st = st;
    if (threadIdx.x == 0) (void)xb_add(&bar[XB_XCNT(b.x)], 1u);
    return b;
}
__device__ __forceinline__ void xcd_barrier_complete(unsigned* bar, unsigned x, unsigned& nloc, unsigned& nx) {
    const unsigned G = gridDim.x * gridDim.y * gridDim.z;
    unsigned sum, cnt, mine, sp = 0u;
    for (;;) {
        sum = 0u; cnt = 0u; mine = 0u;
#pragma unroll
        for (unsigned j = 0; j < 16; ++j) { const unsigned c = xb_ld(&bar[XB_XCNT(j)]); sum += c; cnt += (c > 0u) ? 1u : 0u; mine = (j == x) ? c : mine; }
        if (sum == G) break;
        __builtin_amdgcn_s_sleep(1);
        if ((++sp & 255u) == 0u) { if (xb_ld(&bar[XB_TMO])) break; if (sp > XB_SPIN_CAP) { atomicAdd(&bar[XB_TMO], 1u); break; } }
    }
    nloc = mine > 0u ? mine : 1u; nx = cnt > 0u ? cnt : 1u;
}

__device__ __forceinline__ void xcd_barrier(const XcdBarrier& b) {
    asm volatile("s_waitcnt vmcnt(0)" ::: "memory");
    __syncthreads();
    if (threadIdx.x == 0) {
        unsigned* bar = b.bar;
        __builtin_amdgcn_s_waitcnt(0);
        unsigned nloc = b.st[0], nx = b.st[1];
        if (nloc == 0u) { xcd_barrier_complete(bar, b.x, nloc, nx); b.st[0] = nloc; b.st[1] = nx; }
        const unsigned old = xb_add(&bar[XB_XSUB(b.x)], 1u);
        const unsigned gen = old / nloc;
        if (old + 1u == (gen + 1u) * nloc) {
            __builtin_amdgcn_fence(__ATOMIC_RELEASE, "agent");
            asm volatile("s_waitcnt vmcnt(0)" ::: "memory");
            const unsigned og = xb_add(&bar[XB_TOP], 1u);
            const unsigned tg = og / nx;
            if (og + 1u == (tg + 1u) * nx) xb_add(&bar[XB_TOPGEN], 1u);
            else XB_SPIN(xb_ld(&bar[XB_TOPGEN]) == tg, bar);
            __builtin_amdgcn_fence(__ATOMIC_ACQUIRE, "agent");
            xb_add(&bar[XB_XGEN(b.x)], 1u);
            asm volatile("s_waitcnt vmcnt(0)" ::: "memory");
        } else {
            XB_SPIN(xb_ld(&bar[XB_XGEN(b.x)]) == gen, bar);
            __builtin_amdgcn_fence(__ATOMIC_ACQUIRE, "agent");
            asm volatile("s_waitcnt vmcnt(0)" ::: "memory");
        }
    }
    __syncthreads();
}
struct Frame {
    LAS unsigned char* lds;
    volatile LAS unsigned* MISC;
    int tid, lane, wave, wg, G, vwg;
    unsigned char* ws;
};
__device__ __forceinline__ void* ldptr(Frame& F, int i) {
    const unsigned long long v = ((const LAS unsigned long long*)(F.lds + L_PTR))[i];
    const unsigned lo = __builtin_amdgcn_readfirstlane((unsigned)v), hi = __builtin_amdgcn_readfirstlane((unsigned)(v >> 32));
    return (void*)(((unsigned long long)hi << 32) | lo);
}
__device__ __forceinline__ float shfl_idx_l(float v, int src) { return __builtin_bit_cast(float, __builtin_amdgcn_ds_bpermute(src << 2, __builtin_bit_cast(int, v))); }
__device__ __forceinline__ float shfl_xor_l(float v, int o, int lane) { return shfl_idx_l(v, lane ^ o); }
__device__ __forceinline__ float xh_sum(float v) { const int x = __builtin_bit_cast(int, v); const auto r = __builtin_amdgcn_permlane32_swap(x, x, false, false); return __builtin_bit_cast(float, (int)r[0]) + __builtin_bit_cast(float, (int)r[1]); }
__device__ __forceinline__ float xh_max(float v) { const int x = __builtin_bit_cast(int, v); const auto r = __builtin_amdgcn_permlane32_swap(x, x, false, false); return fmaxf(__builtin_bit_cast(float, (int)r[0]), __builtin_bit_cast(float, (int)r[1])); }
__device__ __forceinline__ float xh_other(float v, int hi) { const int x = __builtin_bit_cast(int, v); const auto r = __builtin_amdgcn_permlane32_swap(x, x, false, false); return hi ? __builtin_bit_cast(float, (int)r[0]) : __builtin_bit_cast(float, (int)r[1]); }
__device__ __forceinline__ float wave_sum(float v, int lane) {
    (void)lane;
    int x = __builtin_bit_cast(int, v);
    v += __builtin_bit_cast(float, __builtin_amdgcn_update_dpp(0, x, 0xB1, 0xF, 0xF, true)); x = __builtin_bit_cast(int, v);
    v += __builtin_bit_cast(float, __builtin_amdgcn_update_dpp(0, x, 0x4E, 0xF, 0xF, true)); x = __builtin_bit_cast(int, v);
    v += __builtin_bit_cast(float, __builtin_amdgcn_update_dpp(0, x, 0x124, 0xF, 0xF, true)); x = __builtin_bit_cast(int, v);
    v += __builtin_bit_cast(float, __builtin_amdgcn_update_dpp(0, x, 0x128, 0xF, 0xF, true)); x = __builtin_bit_cast(int, v);
    const float r0 = __builtin_bit_cast(float, __builtin_amdgcn_readlane(x, 0)), r1 = __builtin_bit_cast(float, __builtin_amdgcn_readlane(x, 16));
    const float r2 = __builtin_bit_cast(float, __builtin_amdgcn_readlane(x, 32)), r3 = __builtin_bit_cast(float, __builtin_amdgcn_readlane(x, 48));
    return (r0 + r1) + (r2 + r3);
}

__device__ __forceinline__ void tr_item(const float* W, int ldw, int K, int nblk, int item, bf16* WT, int mode, int half, LAS float* scr, int lane) {
    const int kb = item / nblk, nb = item - kb * nblk, k0 = 64 * kb, n0 = 32 * nb;
    const int drow0 = mode == 0 ? n0 : ((n0 >> 7) * 256 + half * 128 + (n0 & 127));
    float wv[32];
    const GAS float* wsrc = (const GAS float*)W + (size_t)(k0 + (lane >> 5)) * ldw + n0 + (lane & 31);
#pragma unroll
    for (int i = 0; i < 32; ++i) wv[i] = __builtin_nontemporal_load(wsrc + (size_t)(2 * i) * ldw);
#pragma unroll
    for (int i = 0; i < 32; ++i) scr[(2 * i + (lane >> 5)) * 33 + (lane & 31)] = wv[i];
    LDS_WAIT(); asm volatile("" ::: "memory");
    const int c = lane & 7;
#pragma unroll
    for (int j = 0; j < 4; ++j) { const int n = (lane >> 3) + 8 * j; const LAS float* s = scr + (8 * c) * 33 + n;
        v4u o; o.x = pk2(s[0 * 33], s[1 * 33]); o.y = pk2(s[2 * 33], s[3 * 33]); o.z = pk2(s[4 * 33], s[5 * 33]); o.w = pk2(s[6 * 33], s[7 * 33]);
        *(GAS v4u*)(WT + (size_t)(drow0 + n) * K + k0 + 8 * c) = o; }
    LDS_WAIT(); asm volatile("" ::: "memory");
}
__device__ __forceinline__ void tr_item_f8(const float* W, int ldw, int K, int nblk, int item, unsigned char* WT, int mode, int half, float scale, LAS float* scr, int lane) {
    const int kb = item / nblk, nb = item - kb * nblk, k0 = 128 * kb, n0 = 32 * nb;
    const int drow0 = mode == 0 ? n0 : ((n0 >> 7) * 256 + half * 128 + (n0 & 127));
    float wv[64];
    const GAS float* wsrc = (const GAS float*)W + (size_t)(k0 + (lane >> 5)) * ldw + n0 + (lane & 31);
#pragma unroll
    for (int i = 0; i < 64; ++i) wv[i] = __builtin_nontemporal_load(wsrc + (size_t)(2 * i) * ldw);
#pragma unroll
    for (int i = 0; i < 64; ++i) scr[(2 * i + (lane >> 5)) * 32 + (((lane & 31) + 4 * (i >> 3)) & 31)] = wv[i];
    LDS_WAIT(); asm volatile("" ::: "memory");
    const int c = lane & 7;
#pragma unroll
    for (int j = 0; j < 4; ++j) { const int n = (lane >> 3) + 8 * j; const LAS float* s = scr + (16 * c) * 32 + ((n + 4 * c) & 31);
        v4u o; o.x = pg8::pk4_f8(s[0 * 32] * scale, s[1 * 32] * scale, s[2 * 32] * scale, s[3 * 32] * scale); o.y = pg8::pk4_f8(s[4 * 32] * scale, s[5 * 32] * scale, s[6 * 32] * scale, s[7 * 32] * scale);
        o.z = pg8::pk4_f8(s[8 * 32] * scale, s[9 * 32] * scale, s[10 * 32] * scale, s[11 * 32] * scale); o.w = pg8::pk4_f8(s[12 * 32] * scale, s[13 * 32] * scale, s[14 * 32] * scale, s[15 * 32] * scale);
        *(GAS v4u*)(WT + (size_t)(drow0 + n) * K + k0 + 16 * c) = o; }
    LDS_WAIT(); asm volatile("" ::: "memory");
}
template <bool F8D, bool L8, bool L8O> __device__ __forceinline__ void convert_even(Frame& F, const float* w_in, const float* w_out, const float* w_g, const float* w_u, const float* w_d, int wg0 = 0) {
    if (F.wg < wg0) return;
    LAS float* scr = (LAS float*)(F.lds + F.wave * 16384);
    const int gw = (F.wg - wg0) * NWAVES + F.wave, NGW = (F.G - wg0) * NWAVES;
    constexpr int I0 = (L8 ? 8 : 16) * 96, I1 = (L8O ? 8 : 16) * 32, I2 = (F8D ? 8 : 16) * 88, I4 = (F8D ? 22 : 44) * 32;
    bf16* Wqkv = (bf16*)(F.ws + WS_WQKV); bf16* Wo = (bf16*)(F.ws + WS_WO); bf16* Wgu = (bf16*)(F.ws + WS_WGU); bf16* Wd = (bf16*)(F.ws + WS_WD);
    for (int it = gw; it < I0 + I1 + 2 * I2 + I4; it += NGW) {
        int r = it;
        if (r < I0) { if (L8) tr_item_f8(w_in, NQKV, D, 96, r, (unsigned char*)Wqkv, 0, 0, W_GU_SCALE, scr, F.lane); else tr_item(w_in, NQKV, D, 96, r, Wqkv, 0, 0, scr, F.lane); continue; } r -= I0;
        if (r < I1) { if (L8O) tr_item_f8(w_out, D, D, 32, r, (unsigned char*)Wo, 0, 0, W_GU_SCALE, scr, F.lane); else tr_item(w_out, D, D, 32, r, Wo, 0, 0, scr, F.lane); continue; } r -= I1;
        if (F8D) {
            if (r < I2) { tr_item_f8(w_g, DFF, D, 88, r, (unsigned char*)Wgu, 1, 0, W_GU_SCALE, scr, F.lane); continue; } r -= I2;
            if (r < I2) { tr_item_f8(w_u, DFF, D, 88, r, (unsigned char*)Wgu, 1, 1, W_GU_SCALE, scr, F.lane); continue; } r -= I2;
            tr_item_f8(w_d, D, DFF, 32, r, (unsigned char*)Wd, 0, 0, W_D_SCALE, scr, F.lane);
        } else {
            if (r < I2) { tr_item(w_g, DFF, D, 88, r, Wgu, 1, 0, scr, F.lane); continue; } r -= I2;
            if (r < I2) { tr_item(w_u, DFF, D, 88, r, Wgu, 1, 1, scr, F.lane); continue; } r -= I2;
            tr_item(w_d, D, DFF, 32, r, Wd, 0, 0, scr, F.lane);
        }
    }
}
template <bool L8, bool L8O> __device__ __forceinline__ void convert_odd(Frame& F, const float* w_in, const float* w_out, const float* w_g, const float* w_u, const float* w_d) {
    LAS float* scr = (LAS float*)(F.lds + F.wave * 16384);
    const int gw = F.wg * NWAVES + F.wave, NGW = F.G * NWAVES;
    constexpr int I0 = (L8 ? 8 : 16) * 96, I1 = (L8O ? 8 : 16) * 32, IE = 8 * 112, ID = 28 * 32;
    bf16* Win = (bf16*)(F.ws + WS_WIN); bf16* Wo = (bf16*)(F.ws + WS_WO); unsigned char* Wegu = F.ws + WS_WEGU; unsigned char* Wed = F.ws + WS_WED;
    for (int it = gw; it < I0 + I1 + NEXP * (2 * IE + ID); it += NGW) {
        int r = it;
        if (r < I0) { if (L8) tr_item_f8(w_in, MLW, D, 96, r, (unsigned char*)Win, 0, 0, W_GU_SCALE, scr, F.lane); else tr_item(w_in, MLW, D, 96, r, Win, 0, 0, scr, F.lane); continue; } r -= I0;
        if (r < I1) { if (L8O) tr_item_f8(w_out, D, D, 32, r, (unsigned char*)Wo, 0, 0, W_GU_SCALE, scr, F.lane); else tr_item(w_out, D, D, 32, r, Wo, 0, 0, scr, F.lane); continue; } r -= I1;
        if (r < NEXP * IE) { const int e = r / IE; tr_item_f8(w_g + (size_t)e * D * DFFE, DFFE, D, 112, r - e * IE, Wegu + (size_t)e * 2 * DFFE * D, 1, 0, W_GU_SCALE, scr, F.lane); continue; } r -= NEXP * IE;
        if (r < NEXP * IE) { const int e = r / IE; tr_item_f8(w_u + (size_t)e * D * DFFE, DFFE, D, 112, r - e * IE, Wegu + (size_t)e * 2 * DFFE * D, 1, 1, W_GU_SCALE, scr, F.lane); continue; } r -= NEXP * IE;
        { const int e = r / ID; tr_item_f8(w_d + (size_t)e * DFFE * D, D, DFFE, 32, r - e * ID, Wed + (size_t)e * D * DFFE, 0, 0, W_D_SCALE, scr, F.lane); }
    }
}

template <bool COMBINE, int EXTRA, bool XF8 = false, bool HF32 = false>
__device__ __forceinline__ void norm_phase(Frame& F, const void* hin, bf16* hout, const float* gain, bf16* xn, float* fout,
                                           const float* wsmall  , const float* b_i, const float* b_f) {
    LAS float* WL = (LAS float*)F.lds;
    LAS int* cnt = (LAS int*)(F.lds + L_CNT);
    if (EXTRA == 1) { for (int idx = F.tid; idx < 8 * D; idx += NTHREADS) { const int k = idx >> 3, e = idx & 7; WL[e * D + k] = wsmall[(size_t)k * MLW + NQKV + e]; } }
    if (EXTRA == 2) { for (int idx = F.tid; idx < 8 * D; idx += NTHREADS) { const int k = idx >> 3, e = idx & 7; WL[e * D + k] = wsmall[idx]; }
                      if (F.tid < 8) cnt[F.tid] = 0; }
    if (EXTRA == 1 || EXTRA == 2) __syncthreads();
    const int* tokp = (const int*)(F.ws + WS_TOKP); const float* tokw = (const float*)(F.ws + WS_TOKW); const bf16* Y = (const bf16*)(F.ws + WS_Y);
    f32x4 g[4];
#pragma unroll
    for (int j = 0; j < 4; ++j) g[j] = ((const GAS f32x4*)gain)[F.lane + 64 * j];
    const int row0 = F.wg * 128 + F.wave * 16;
    for (int i0 = 0; i0 < 16; i0 += 2) {
        f32x4 hf[2][4]; v2u hr[2][4], ya[2][4], yb[2][4]; int p0_[2], p1_[2]; float w0_[2], w1_[2];
#pragma unroll
        for (int u = 0; u < 2; ++u) { const int row = row0 + i0 + u;
            if (COMBINE) { p0_[u] = tokp[2 * row]; p1_[u] = tokp[2 * row + 1]; w0_[u] = tokw[2 * row]; w1_[u] = tokw[2 * row + 1]; }
#pragma unroll
            for (int j = 0; j < 4; ++j) { if (HF32) hf[u][j] = __builtin_nontemporal_load((const GAS f32x4*)((const float*)hin + (size_t)row * D) + F.lane + 64 * j); else hr[u][j] = __builtin_nontemporal_load((const GAS v2u*)((const bf16*)hin + (size_t)row * D) + F.lane + 64 * j); } }
        if (COMBINE) {
#pragma unroll
            for (int u = 0; u < 2; ++u)
#pragma unroll
                for (int j = 0; j < 4; ++j) { ya[u][j] = __builtin_nontemporal_load((const GAS v2u*)(Y + (size_t)p0_[u] * D) + F.lane + 64 * j); yb[u][j] = __builtin_nontemporal_load((const GAS v2u*)(Y + (size_t)p1_[u] * D) + F.lane + 64 * j); } }
#pragma unroll
      for (int u = 0; u < 2; ++u) {
        const int i = i0 + u, row = row0 + i;
        f32x4 v[4];
#pragma unroll
        for (int j = 0; j < 4; ++j) { if (HF32) v[j] = hf[u][j]; else { const v2u t = hr[u][j]; v[j] = (f32x4){bflo(t.x), bfhi(t.x), bflo(t.y), bfhi(t.y)}; } }
        if (COMBINE) {
            const float w0 = w0_[u], w1 = w1_[u];
#pragma unroll
            for (int j = 0; j < 4; ++j) { const v2u a = ya[u][j], b = yb[u][j];
                v[j].x += w0 * bflo(a.x) + w1 * bflo(b.x); v[j].y += w0 * bfhi(a.x) + w1 * bfhi(b.x); v[j].z += w0 * bflo(a.y) + w1 * bflo(b.y); v[j].w += w0 * bfhi(a.y) + w1 * bfhi(b.y); }
            if (EXTRA != 3) {
#pragma unroll
                for (int j = 0; j < 4; ++j) { v2u o; o.x = pk2(v[j].x, v[j].y); o.y = pk2(v[j].z, v[j].w); ((GAS v2u*)(hout + (size_t)row * D))[F.lane + 64 * j] = o; } }
        }
        float ss = 0.f;
#pragma unroll
        for (int j = 0; j < 4; ++j) ss += (v[j].x * v[j].x + v[j].y * v[j].y) + (v[j].z * v[j].z + v[j].w * v[j].w);
        const float rstd = 1.0f / sqrtf(wave_sum(ss, F.lane) * (1.0f / D) + EPS);
#pragma unroll
        for (int j = 0; j < 4; ++j) v[j] = v[j] * rstd * g[j];
        if (EXTRA == 3) {
#pragma unroll
            for (int j = 0; j < 4; ++j) __builtin_nontemporal_store(v[j], (GAS f32x4*)(fout + (size_t)row * D) + F.lane + 64 * j);
        } else if (EXTRA == 4 || XF8) {
#pragma unroll
            for (int j = 0; j < 4; ++j) ((GAS unsigned*)((unsigned char*)xn + (size_t)row * D))[F.lane + 64 * j] = pg8::pk4_f8(v[j].x * X_SCALE, v[j].y * X_SCALE, v[j].z * X_SCALE, v[j].w * X_SCALE);
        } else {
#pragma unroll
            for (int j = 0; j < 4; ++j) { v2u o; o.x = pk2(v[j].x, v[j].y); o.y = pk2(v[j].z, v[j].w); ((GAS v2u*)(xn + (size_t)row * D))[F.lane + 64 * j] = o; }
        }
        if (EXTRA == 1 || EXTRA == 2) {
            float lg[8];
#pragma unroll
            for (int e = 0; e < 8; ++e) { float p = 0.f;
#pragma unroll
                for (int j = 0; j < 4; ++j) { const f32x4 w = *(const LAS f32x4*)(WL + e * D + 256 * j + 4 * F.lane); p += (v[j].x * w.x + v[j].y * w.y) + (v[j].z * w.z + v[j].w * w.w); }
                lg[e] = wave_sum(p, F.lane); }
            if (EXTRA == 1) {
                float* gates = (float*)(F.ws + WS_GATES);
                float val = 0.f;
#pragma unroll
                for (int e = 0; e < 8; ++e) if (F.lane == e) val = lg[e];
                if (F.lane < 4) { const float ip = 15.0f * tanhf((val + b_i[F.lane]) * (1.0f / 15.0f)); gates[(size_t)row * 8 + F.lane] = ip; }
                else if (F.lane < 8) { const float fp = 15.0f * tanhf((val + b_f[F.lane - 4]) * (1.0f / 15.0f)); gates[(size_t)row * 8 + F.lane] = fminf(fp, 0.f) - log1pf(__expf(-fabsf(fp))); }
            } else {
                int e0 = 0; float v0 = lg[0];
#pragma unroll
                for (int e = 1; e < 8; ++e) if (lg[e] > v0) { v0 = lg[e]; e0 = e; }
                int e1 = -1; float v1 = -INFINITY;
#pragma unroll
                for (int e = 0; e < 8; ++e) if (e != e0 && lg[e] > v1) { v1 = lg[e]; e1 = e; }
                const float ex = __expf(v1 - v0), w0 = 1.0f / (1.0f + ex), w1 = ex * w0;
                if (F.lane == 0) {
                    ((int*)(F.ws + WS_TOKE))[row] = e0 | (e1 << 8);
                    ((float*)(F.ws + WS_TOKW))[2 * row] = w0; ((float*)(F.ws + WS_TOKW))[2 * row + 1] = w1;
                    __hip_atomic_fetch_add(cnt + e0, 1, __ATOMIC_RELAXED, __HIP_MEMORY_SCOPE_WORKGROUP);
                    __hip_atomic_fetch_add(cnt + e1, 1, __ATOMIC_RELAXED, __HIP_MEMORY_SCOPE_WORKGROUP);
                }
            }
        }
    }
    }
    if (EXTRA == 2) { __syncthreads(); if (F.tid < 8) ((int*)(F.ws + WS_WGCNT))[F.wg * 8 + F.tid] = cnt[F.tid]; }
    if (EXTRA == 1 || EXTRA == 2) __syncthreads();
}

__device__ __forceinline__ void moe_assign_gather(Frame& F) {
    LAS int* S = (LAS int*)(F.lds + L_SCR);
    LAS int* tot = S; LAS int* pre = S + 8; LAS int* eo = S + 16  ; LAS int* base = S + 32; LAS int* te = S + 64  ; LAS int* lpos = S + 192  ;
    LAS int* big = (LAS int*)F.lds;
    const int* wgcnt = (const int*)(F.ws + WS_WGCNT);
    for (int i = F.tid; i < F.G * 8; i += NTHREADS) big[i] = ld_i32(wgcnt + i);
    if (F.tid < 128) te[F.tid] = ld_i32((const int*)(F.ws + WS_TOKE) + F.wg * 128 + F.tid);
    __syncthreads();
    { const int e = F.wave;
      int c4[4], sl = 0;
#pragma unroll
      for (int k = 0; k < 4; ++k) { c4[k] = big[(4 * F.lane + k) * 8 + e]; sl += c4[k]; }
      int inc = sl;
#pragma unroll
      for (int o = 1; o < 64; o <<= 1) { const int y = __builtin_amdgcn_ds_bpermute(((F.lane - o) & 63) << 2, inc); if (F.lane >= o) inc += y; }
      const int wq = F.wg >> 2, wr4 = F.wg & 3;
      int mine = inc - sl;
#pragma unroll
      for (int k = 0; k < 3; ++k) if (k < wr4) mine += c4[k];
      const int p = __builtin_amdgcn_ds_bpermute(wq << 2, mine), t = __builtin_amdgcn_ds_bpermute(63 << 2, inc);
      if (F.lane == 0) { tot[e] = t; pre[e] = p; } }
    __syncthreads();
    if (F.tid == 0) { int o = 0; for (int e = 0; e < 8; ++e) { eo[e] = o; base[e] = o + pre[e]; o += (tot[e] + 255) & ~255; } eo[8] = o;
        if (F.wg == 0) { int* g = (int*)(F.ws + WS_EOFF); for (int e = 0; e < 9; ++e) g[e] = eo[e]; g[9] = o >> 8; } }
    __syncthreads();
    { const int e = F.wave;
      const int w0 = te[2 * F.lane], w1 = te[2 * F.lane + 1];
      const int m0 = (w0 & 255) == e, m1 = (w0 >> 8) == e, m2 = (w1 & 255) == e, m3 = (w1 >> 8) == e, cl = m0 + m1 + m2 + m3;
      int inc = cl;
#pragma unroll
      for (int o = 1; o < 64; o <<= 1) { const int y = __builtin_amdgcn_ds_bpermute(((F.lane - o) & 63) << 2, inc); if (F.lane >= o) inc += y; }
      int b = base[e] + inc - cl;
      if (m0) lpos[4 * F.lane] = b++; if (m1) lpos[4 * F.lane + 1] = b++; if (m2) lpos[4 * F.lane + 2] = b++; if (m3) lpos[4 * F.lane + 3] = b++; }
    __syncthreads();
    if (F.tid < 256) ((int*)(F.ws + WS_TOKP))[F.wg * 256 + F.tid] = lpos[F.tid];
    const unsigned char* XN8 = F.ws + WS_XN; unsigned char* XG = F.ws + WS_XG;
    { v4u rr[16];
#pragma unroll
      for (int k = 0; k < 16; ++k) rr[k] = __builtin_nontemporal_load((const GAS v4u*)(XN8 + (size_t)(F.wg * 128 + F.wave * 16 + k) * D) + F.lane);
#pragma unroll
      for (int k = 0; k < 16; ++k) { const int lt = F.wave * 16 + k;
#pragma unroll
        for (int s2 = 0; s2 < 2; ++s2) { const int pos = lpos[2 * lt + s2]; ((GAS v4u*)(XG + (size_t)pos * D))[F.lane] = rr[k]; } } }
    if (F.wg < 8) { const int r0 = eo[F.wg] + tot[F.wg], r1 = eo[F.wg + 1]; const v4u z = (v4u){0u, 0u, 0u, 0u};
        for (int r = r0 + F.wave; r < r1; r += NWAVES) ((GAS v4u*)(XG + (size_t)r * D))[F.lane] = z; }
    __syncthreads();
}
__device__ __forceinline__ int moe_tile_table(Frame& F) {
    LAS int* eo = (LAS int*)(F.lds + L_SCR); LAS int* texp = (LAS int*)(F.lds + L_TEXP);
    __syncthreads();
    if (F.tid < 10) eo[F.tid] = ld_i32((const int*)(F.ws + WS_EOFF) + F.tid);
    __syncthreads();
    const int nt = eo[9];
    for (int t = F.tid; t < nt; t += NTHREADS) { int e = 0;
#pragma unroll
        for (int j = 1; j < 8; ++j) e += (eo[j] <= 256 * t) ? 1 : 0;
        texp[t] = e; }
    __syncthreads();
    return nt;
}

typedef short bf16x8_t __attribute__((ext_vector_type(8)));
typedef float f32x16 __attribute__((ext_vector_type(16)));
#define MFMA32(a, b, c) __builtin_amdgcn_mfma_f32_32x32x16_bf16((a), (b), (c), 0, 0, 0)
__device__ __forceinline__ unsigned cvtpk(float lo, float hi) { typedef float f2 __attribute__((ext_vector_type(2))); typedef __bf16 b2 __attribute__((ext_vector_type(2))); f2 v = {lo, hi}; b2 b = __builtin_convertvector(v, b2); return __builtin_bit_cast(unsigned, b); }
__device__ __forceinline__ bf16x8_t mk_frag(unsigned a, unsigned b, unsigned c, unsigned d) { v4u w = {a, b, c, d}; return __builtin_bit_cast(bf16x8_t, w); }
constexpr int NRT = T / 32;
__device__ __forceinline__ const bf16* uf_block(const bf16* UF, int colblock, int rowtile) { return UF + ((size_t)colblock * NRT + rowtile) * 512; }
__device__ __forceinline__ const bf16* uf_piece(const bf16* UF, int row, int c0) { return UF + ((size_t)(c0 >> 4) * NRT + (row >> 5)) * 512 + ((row & 31) + 32 * ((c0 >> 3) & 1)) * 8; }

__device__ __forceinline__ void mlstm_scalars(Frame& F) {
    const float* gates = (const float*)(F.ws + WS_GATES); float* TA = (float*)(F.ws + WS_TA); float* TB = (float*)(F.ws + WS_TU); float* TP = (float*)(F.ws + WS_TM); float* CG = (float*)(F.ws + WS_CG);
    for (int task = F.wg * NWAVES + F.wave; task < 2048; task += F.G * NWAVES) {
        const int bh = task >> 6, c = task & 63, b = bh >> 2, hh = bh & 3;
        const size_t tok = (size_t)b * SEQ + 64 * c + F.lane;
        const float li = gates[tok * 8 + hh], lf = gates[tok * 8 + 4 + hh];
        float bc = lf;
#pragma unroll
        for (int o = 1; o < 64; o <<= 1) { const float y = shfl_idx_l(bc, (F.lane - o) & 63); if (F.lane >= o) bc += y; }
        const float a = li - bc; float pm = a;
#pragma unroll
        for (int o = 1; o < 64; o <<= 1) { const float y = shfl_idx_l(pm, (F.lane - o) & 63); if (F.lane >= o) pm = fmaxf(pm, y); }
        const int ti = bh * SEQ + 64 * c + F.lane;
        TA[ti] = a; TB[ti] = bc; TP[ti] = pm;
        if (F.lane == 63) { CG[(bh * 64 + c) * 2] = bc; CG[(bh * 64 + c) * 2 + 1] = pm; }
    }
}
__device__ __forceinline__ void conv8(const bf16* UF, const float* cw, const float* cb, int row, int s, int c0, float sc, float (&a)[8]) {
    { const f32x4 b0 = *(const GAS f32x4*)(cb + c0), b1 = *(const GAS f32x4*)(cb + c0 + 4); a[0] = b0.x; a[1] = b0.y; a[2] = b0.z; a[3] = b0.w; a[4] = b1.x; a[5] = b1.y; a[6] = b1.z; a[7] = b1.w; }
#pragma unroll
    for (int j = 0; j < 4; ++j) {
        if (s - 3 + j >= 0) {
            const v4u x = *(const GAS v4u*)uf_piece(UF, row - 3 + j, c0);
            const f32x4 w0 = *(const GAS f32x4*)(cw + j * 1024 + c0), w1 = *(const GAS f32x4*)(cw + j * 1024 + c0 + 4);
            a[0] += w0.x * bflo(x.x); a[1] += w0.y * bfhi(x.x); a[2] += w0.z * bflo(x.y); a[3] += w0.w * bfhi(x.y);
            a[4] += w1.x * bflo(x.z); a[5] += w1.y * bfhi(x.z); a[6] += w1.z * bflo(x.w); a[7] += w1.w * bfhi(x.w);
        }
    }
#pragma unroll
    for (int e = 0; e < 8; ++e) a[e] = a[e] * __builtin_amdgcn_rcpf(1.0f + __expf(-a[e])) * sc;
}
__device__ __forceinline__ void mlstm_qconv(Frame& F, const float* cw, const float* cb, int wg0) {
    const bf16* UF = (const bf16*)(F.ws + WS_U); bf16* QF = (bf16*)(F.ws + WS_QF);
    const int nw = (F.G - wg0) * NWAVES, w = (F.wg - wg0) * NWAVES + F.wave;
    const int cbk = w & 31, c0 = 16 * cbk + 8 * (F.lane >> 5), rstep = nw >> 5;
    float wt[4][8], bs[8];
    { const f32x4 b0 = *(const GAS f32x4*)(cb + c0), b1 = *(const GAS f32x4*)(cb + c0 + 4); bs[0] = b0.x; bs[1] = b0.y; bs[2] = b0.z; bs[3] = b0.w; bs[4] = b1.x; bs[5] = b1.y; bs[6] = b1.z; bs[7] = b1.w; }
#pragma unroll
    for (int j = 0; j < 4; ++j) { const f32x4 w0 = *(const GAS f32x4*)(cw + j * 1024 + c0), w1 = *(const GAS f32x4*)(cw + j * 1024 + c0 + 4);
        wt[j][0] = w0.x; wt[j][1] = w0.y; wt[j][2] = w0.z; wt[j][3] = w0.w; wt[j][4] = w1.x; wt[j][5] = w1.y; wt[j][6] = w1.z; wt[j][7] = w1.w; }
    constexpr int U = 4;
    for (int rt0 = w >> 5; rt0 < NRT; rt0 += U * rstep) {
        v4u x[U][4];
#pragma unroll
        for (int u = 0; u < U; ++u) { const int rt = rt0 + u * rstep, row = 32 * rt + (F.lane & 31), sq = row & (SEQ - 1);
#pragma unroll
            for (int j = 0; j < 4; ++j) { x[u][j] = (v4u){0u, 0u, 0u, 0u}; if (rt < NRT && sq - 3 + j >= 0) x[u][j] = *(const GAS v4u*)uf_piece(UF, row - 3 + j, c0); } }
#pragma unroll
        for (int u = 0; u < U; ++u) { const int rt = rt0 + u * rstep; if (rt >= NRT) break;
            float a[8];
#pragma unroll
            for (int e = 0; e < 8; ++e) a[e] = bs[e];
#pragma unroll
            for (int j = 0; j < 4; ++j) { const v4u xx = x[u][j];
                a[0] += wt[j][0] * bflo(xx.x); a[1] += wt[j][1] * bfhi(xx.x); a[2] += wt[j][2] * bflo(xx.y); a[3] += wt[j][3] * bfhi(xx.y);
                a[4] += wt[j][4] * bflo(xx.z); a[5] += wt[j][5] * bfhi(xx.z); a[6] += wt[j][6] * bflo(xx.w); a[7] += wt[j][7] * bfhi(xx.w); }
#pragma unroll
            for (int e = 0; e < 8; ++e) a[e] = a[e] * __builtin_amdgcn_rcpf(1.0f + __expf(-a[e]));
            v4u o; o.x = pk2(a[0], a[1]); o.y = pk2(a[2], a[3]); o.z = pk2(a[4], a[5]); o.w = pk2(a[6], a[7]);
            *(GAS v4u*)(QF + (((size_t)cbk * NRT + rt) * 64 + F.lane) * 8) = o; }
    }
}
__device__ __forceinline__ void mlstm_prep(Frame& F, const float* cw, const float* cb) {
    const bf16* UF = (const bf16*)(F.ws + WS_U); bf16* QF = (bf16*)(F.ws + WS_QF); bf16* KF = (bf16*)(F.ws + WS_KF); bf16* KWF = (bf16*)(F.ws + WS_KT); bf16* VF = (bf16*)(F.ws + WS_VT);
    float* CP = (float*)(F.ws + WS_CP); const float* TA = (const float*)(F.ws + WS_TA);
    LAS float* wbt = (LAS float*)(F.lds + L_SCR);
    { const float* CG = (const float*)(F.ws + WS_CG);
      float gq[4], aq[4];
#pragma unroll
      for (int i = 0; i < 4; ++i) { const int bh = F.wave + 8 * i; gq[i] = CG[(bh * 64 + F.lane) * 2]; aq[i] = CG[(bh * 64 + F.lane) * 2 + 1]; }
#pragma unroll
      for (int i = 0; i < 4; ++i) { const int bh = F.wave + 8 * i; const float g = gq[i];
        float p = g, q = g + aq[i];
#pragma unroll
        for (int o = 1; o < 64; o <<= 1) { const float pp = shfl_idx_l(p, (F.lane - o) & 63), qq = shfl_idx_l(q, (F.lane - o) & 63); if (F.lane >= o) { q = fmaxf(qq + p, q); p = pp + p; } }
        const float m_new = fmaxf(p, q);
        float m_prev = shfl_idx_l(m_new, (F.lane - 1) & 63); if (F.lane == 0) m_prev = 0.f;
        wbt[bh * 64 + F.lane] = g - m_new;
        if (F.wg == 0) { float* cp = CP + (bh * 64 + F.lane) * 4; cp[0] = m_prev; cp[1] = g - m_new; cp[2] = __expf(g + m_prev - m_new); cp[3] = 0.f; } }
    }
    __syncthreads();
    {
        const int hh0 = (F.wg >> 6) & 3;
        float wt[2][4][8], bs[2][8]; int tl_[2], d0_[2];
#pragma unroll
        for (int pp = 0; pp < 2; ++pp) { const int p = F.tid + 512 * pp, blk = p >> 6, slot = p & 63, kd = blk >> 1, th = blk & 1; tl_[pp] = 32 * th + (slot & 31); d0_[pp] = 16 * kd + 8 * (slot >> 5);
            const int c0 = 512 + 128 * hh0 + d0_[pp];
            { const f32x4 b0 = *(const GAS f32x4*)(cb + c0), b1 = *(const GAS f32x4*)(cb + c0 + 4); bs[pp][0] = b0.x; bs[pp][1] = b0.y; bs[pp][2] = b0.z; bs[pp][3] = b0.w; bs[pp][4] = b1.x; bs[pp][5] = b1.y; bs[pp][6] = b1.z; bs[pp][7] = b1.w; }
#pragma unroll
            for (int j = 0; j < 4; ++j) { const f32x4 w0 = *(const GAS f32x4*)(cw + j * 1024 + c0), w1 = *(const GAS f32x4*)(cw + j * 1024 + c0 + 4);
                wt[pp][j][0] = w0.x; wt[pp][j][1] = w0.y; wt[pp][j][2] = w0.z; wt[pp][j][3] = w0.w; wt[pp][j][4] = w1.x; wt[pp][j][5] = w1.y; wt[pp][j][6] = w1.z; wt[pp][j][7] = w1.w; } }
        v4u xn[2][4]; float tan_[2];
#define PREP_ISSUE(UN) do { const int bh_ = (UN) >> 6, c_ = (UN) & 63, b_ = bh_ >> 2, hh_ = bh_ & 3; _Pragma("unroll") for (int pp = 0; pp < 2; ++pp) { const int row_ = b_ * SEQ + 64 * c_ + tl_[pp], s_ = 64 * c_ + tl_[pp], c0_ = 512 + 128 * hh_ + d0_[pp]; \
            _Pragma("unroll") for (int j = 0; j < 4; ++j) { xn[pp][j] = (v4u){0u, 0u, 0u, 0u}; if (s_ - 3 + j >= 0) xn[pp][j] = *(const GAS v4u*)uf_piece(UF, row_ - 3 + j, c0_); } \
            tan_[pp] = TA[bh_ * SEQ + 64 * c_ + tl_[pp]]; } } while (0)
        if (F.wg < 2048) PREP_ISSUE(F.wg);
        for (int un = F.wg, buf = 0; un < 2048; un += F.G, buf ^= 1) {
            const int bh = un >> 6, c = un & 63, b = bh >> 2, hh = bh & 3;
            LAS unsigned char* tile = F.lds + buf * 17408;
            v4u x[2][4]; float ta[2];
#pragma unroll
            for (int pp = 0; pp < 2; ++pp) { ta[pp] = tan_[pp];
#pragma unroll
                for (int j = 0; j < 4; ++j) x[pp][j] = xn[pp][j]; }
            if (un + F.G < 2048) PREP_ISSUE(un + F.G);
#pragma unroll
            for (int pp = 0; pp < 2; ++pp) {
                const int tl = tl_[pp], d0 = d0_[pp], slot = (F.tid + 512 * pp) & 63, row = b * SEQ + 64 * c + tl, c0 = 512 + 128 * ((F.G == 256) ? hh0 : hh) + d0;
                float a[8];
#pragma unroll
                for (int e = 0; e < 8; ++e) a[e] = bs[pp][e];
#pragma unroll
                for (int j = 0; j < 4; ++j) { const v4u xx = x[pp][j];
                    a[0] += wt[pp][j][0] * bflo(xx.x); a[1] += wt[pp][j][1] * bfhi(xx.x); a[2] += wt[pp][j][2] * bflo(xx.y); a[3] += wt[pp][j][3] * bfhi(xx.y);
                    a[4] += wt[pp][j][4] * bflo(xx.z); a[5] += wt[pp][j][5] * bfhi(xx.z); a[6] += wt[pp][j][6] * bflo(xx.w); a[7] += wt[pp][j][7] * bfhi(xx.w); }
#pragma unroll
                for (int e = 0; e < 8; ++e) a[e] = a[e] * __builtin_amdgcn_rcpf(1.0f + __expf(-a[e])) * 0.08838834764831845f;
                v4u o; o.x = pk2(a[0], a[1]); o.y = pk2(a[2], a[3]); o.z = pk2(a[4], a[5]); o.w = pk2(a[6], a[7]);
                *(GAS v4u*)(KF + ((size_t)((c0 - 512) >> 4) * NRT + (row >> 5)) * 512 + slot * 8) = o;
                const float wsc = __expf(wbt[bh * 64 + c] + ta[pp]);
                o.x = pk2(a[0] * wsc, a[1] * wsc); o.y = pk2(a[2] * wsc, a[3] * wsc); o.z = pk2(a[4] * wsc, a[5] * wsc); o.w = pk2(a[6] * wsc, a[7] * wsc);
                *(LAS v4u*)(tile + tl * 272 + d0 * 2) = o;
            }
            __syncthreads();
#pragma unroll
            for (int pp = 0; pp < 2; ++pp) {
                const int p = F.tid + 512 * pp, ob = p >> 6, l = p & 63, rtile = ob & 3, tkl = ob >> 2, dd = 32 * rtile + (l & 31), t0 = 16 * tkl + 8 * (l >> 5);
                unsigned w[4];
#pragma unroll
                for (int i = 0; i < 4; ++i) { const unsigned lo = *(const LAS unsigned short*)(tile + (t0 + 2 * i) * 272 + dd * 2), hi = *(const LAS unsigned short*)(tile + (t0 + 2 * i + 1) * 272 + dd * 2); w[i] = lo | (hi << 16); }
                *(GAS v4u*)(KWF + (((size_t)bh * 4 + rtile) * 256 + 4 * c + tkl) * 512 + l * 8) = (v4u){w[0], w[1], w[2], w[3]};
            }
        }
#undef PREP_ISSUE
    }
    __syncthreads();
    for (int idx = F.wg * NTHREADS + F.tid; idx < 32 * 256 * 64; idx += F.G * NTHREADS) {
        const int bh = idx >> 14, tk = (idx >> 6) & 255, l = idx & 63; const unsigned v = (l & 31) == 0 ? 0x3F803F80u : 0u;
        *(GAS v4u*)(VF + (((size_t)bh * 9 + 8) * 256 + tk) * 512 + l * 8) = (v4u){v, v, v, v};
    }
}

constexpr int ST_D = 5, ST_SLOT = 24576, ST_WGS = 160;
#define ST_VMW(n) asm volatile("s_waitcnt vmcnt(" #n ")" ::: "memory")
__device__ __forceinline__ void st_stage(Frame& F, const bf16* KWF, const bf16* VF, int bh, int vt, int c, int slot) {
    LAS unsigned char* S = F.lds + slot * ST_SLOT;
#pragma unroll
    for (int k = 0; k < 2; ++k) { const int p = F.wave + 8 * k, dt = p >> 2, ks = p & 3;
        __builtin_amdgcn_global_load_lds((const unsigned*)(KWF + (((size_t)bh * 4 + dt) * 256 + 4 * c + ks) * 512 + F.lane * 8), (LAS unsigned*)(S + p * 1024), 16, 0, 0); }
    __builtin_amdgcn_global_load_lds((const unsigned*)(VF + (((size_t)bh * 9 + vt) * 256 + 4 * c + (F.wave & 3)) * 512 + F.lane * 8), (LAS unsigned*)(S + (16 + F.wave) * 1024), 16, 0, 0);
}
__device__ __forceinline__ void mlstm_state(Frame& F, const float* cw, const float* cb) {
    if (F.wg >= ST_WGS) { mlstm_qconv(F, cw, cb, ST_WGS); return; }
    const bf16* KWF = (const bf16*)(F.ws + WS_KT); const bf16* VF = (const bf16*)(F.ws + WS_VT); bf16* CTF = (bf16*)(F.ws + WS_CTS);
    const float* CP = (const float*)(F.ws + WS_CP);
    const int bh = F.wg / 5, pr = F.wg - 5 * bh, ug = F.wave >> 2, dt = F.wave & 3, r = F.lane & 31, hi = F.lane >> 5;
    const bool active = (pr < 4) || (ug == 0);
    const int vt = active ? 2 * pr + ug : 8;
    bf16* cts = CTF + ((((size_t)bh * 64) * 9 + vt) * 8 + 2 * dt + hi) * 512 + r * 8;
    const float csv = CP[(bh * 64 + F.lane) * 4 + 2];
    f32x16 acc;
#pragma unroll
    for (int i = 0; i < 16; ++i) acc[i] = 0.f;
    asm volatile("s_waitcnt vmcnt(0)" ::: "memory");
#pragma unroll
    for (int c = 0; c < ST_D - 1; ++c) st_stage(F, KWF, VF, bh, vt, c, c);
    for (int c = 0; c < 64; ++c) {
        if (!active || c == 0) ST_VMW(9); else if (c >= 4) ST_VMW(17); else if (c == 1) ST_VMW(11); else if (c == 2) ST_VMW(13); else ST_VMW(15);
        __builtin_amdgcn_s_barrier();
        const int slot = c % ST_D; const LAS unsigned char* S = F.lds + slot * ST_SLOT;
        v4u kb[4], vb[4];
#pragma unroll
        for (int ks = 0; ks < 4; ++ks) { kb[ks] = *(const LAS v4u*)(S + (dt * 4 + ks) * 1024 + F.lane * 16); vb[ks] = *(const LAS v4u*)(S + (16 + ug * 4 + ks) * 1024 + F.lane * 16); }
        LDS_WAIT(); asm volatile("" ::: "memory");
        { const int cn = c + ST_D - 1; st_stage(F, KWF, VF, bh, vt, cn < 64 ? cn : 63, cn % ST_D); }
        if (active) {
            { unsigned P[8];
#pragma unroll
              for (int g = 0; g < 8; ++g) P[g] = cvtpk(acc[2 * g], acc[2 * g + 1]);
              const auto s0 = __builtin_amdgcn_permlane32_swap(P[0], P[4], false, false), s1 = __builtin_amdgcn_permlane32_swap(P[1], P[5], false, false);
              const auto s2 = __builtin_amdgcn_permlane32_swap(P[2], P[6], false, false), s3 = __builtin_amdgcn_permlane32_swap(P[3], P[7], false, false);
              bf16* dst = cts + (size_t)c * 9 * 8 * 512;
              *(GAS v4u*)dst = (v4u){s0[0], s1[0], s0[1], s1[1]}; *(GAS v4u*)(dst + 32 * 8) = (v4u){s2[0], s3[0], s2[1], s3[1]}; }
            const float cs = __builtin_bit_cast(float, __builtin_amdgcn_readlane(__builtin_bit_cast(int, csv), c));
#pragma unroll
            for (int i = 0; i < 16; ++i) acc[i] *= cs;
#pragma unroll
            for (int ks = 0; ks < 4; ++ks) acc = MFMA32(__builtin_bit_cast(bf16x8_t, kb[ks]), __builtin_bit_cast(bf16x8_t, vb[ks]), acc);
        }
        asm volatile("" ::: "memory");
    }
    asm volatile("s_waitcnt vmcnt(0)" ::: "memory"); __syncthreads();
}
#undef ST_VMW

__device__ __forceinline__ void mo_stage(Frame& F, LAS unsigned char* S, const bf16* QF, const bf16* KF, const bf16* CTF, int bh, int c) {
    const int b = bh >> 2, hh = bh & 3, rt0 = b * 128 + 2 * c;
#pragma unroll
    for (int k = 0; k < 5; ++k) {
        const int blk = F.wave + 8 * k;
        const bf16* src = blk < 16 ? uf_block(QF, 8 * hh + (blk & 7), rt0 + (blk >> 3)) : (blk < 32 ? uf_block(KF, 8 * hh + (blk & 7), rt0 + ((blk - 16) >> 3)) : CTF + (((size_t)(bh * 64 + c) * 9 + 8) * 8 + (blk - 32)) * 512);
        __builtin_amdgcn_global_load_lds((const unsigned*)((const char*)src + F.lane * 16), (LAS unsigned*)(S + blk * 1024), 16, 0, 0);
    }
    if (F.wave < 3 && F.lane < 16) { const float* src = (const float*)(F.ws + (F.wave == 0 ? WS_TA : (F.wave == 1 ? WS_TU : WS_TM))) + bh * SEQ + 64 * c;
        __builtin_amdgcn_global_load_lds((const unsigned*)((const char*)src + F.lane * 16), (LAS unsigned*)(S + 40960 + F.wave * 256), 16, 0, 0); }
}
template <bool H8> __device__ __forceinline__ void mlstm_out(Frame& F, const float* mhg) {
    const bf16* UF = (const bf16*)(F.ws + WS_U); const bf16* QF = (const bf16*)(F.ws + WS_QF); const bf16* KF = (const bf16*)(F.ws + WS_KF); const bf16* VF = (const bf16*)(F.ws + WS_VT);
    const bf16* CTF = (const bf16*)(F.ws + WS_CTS); bf16* HM = (bf16*)(F.ws + WS_HM);
    const float* TA = (const float*)(F.ws + WS_TA); const float* TB = (const float*)(F.ws + WS_TU); const float* TP = (const float*)(F.ws + WS_TM); const float* CP = (const float*)(F.ws + WS_CP);
    constexpr int MO_STRIDE = 41984;
    LAS float* part = (LAS float*)(F.lds + 2 * MO_STRIDE);
    LAS float* mhl = part + 2 * 8 * 64;
    LAS float* qnl = mhl + 256;
    const int r = F.lane & 31, hi = F.lane >> 5, w = F.wave;
    const int unit0 = F.vwg * 8, bh = unit0 >> 6, c0 = unit0 & 63, b = bh >> 2, hh = bh & 3;
    int par = 0;
    mo_stage(F, F.lds, QF, KF, CTF, bh, c0);
    if (F.tid < 256) mhl[F.tid] = mhg[hh * 256 + F.tid];
    float m_next = CP[(bh * 64 + c0) * 4];
    bf16x8_t ncv[8]; v2u nvlo[2][2], nvhi[2][2];
#define MO_PRIV(cc) do { const bf16* ctv_ = CTF + (((size_t)(bh * 64 + (cc)) * 9 + w) * 8) * 512 + F.lane * 8; \
        _Pragma("unroll") for (int ks = 0; ks < 8; ++ks) ncv[ks] = __builtin_nontemporal_load((const GAS bf16x8_t*)(ctv_ + (size_t)ks * 512));   \
        const bf16* vfp_ = VF + (((size_t)bh * 9 + w) * 256 + 4 * (cc)) * 512 + r * 8 + 4 * hi; \
        _Pragma("unroll") for (int st = 0; st < 2; ++st) _Pragma("unroll") for (int sp = 0; sp < 2; ++sp) { const bf16* blk_ = vfp_ + (size_t)(2 * st + sp) * 512; nvlo[st][sp] = *(const GAS v2u*)blk_; nvhi[st][sp] = *(const GAS v2u*)(blk_ + 32 * 8); } } while (0)
    MO_PRIV(c0);
    for (int i = 0; i < 8; ++i) {
        const int c = c0 + i;
        LAS unsigned char* S = F.lds + (i & 1) * MO_STRIDE; const LAS float* SA = (const LAS float*)(S + 40960); const LAS float* SB = SA + 64; const LAS float* SP = SA + 128;
        asm volatile("s_waitcnt vmcnt(0)" ::: "memory"); __builtin_amdgcn_s_barrier(); asm volatile("" ::: "memory");
        if (i + 1 < 8) mo_stage(F, F.lds + ((i + 1) & 1) * MO_STRIDE, QF, KF, CTF, bh, c + 1);
        const size_t row0 = (size_t)b * SEQ + 64 * c; const int tb = bh * SEQ + 64 * c;
        const float m_prev = m_next; if (i + 1 < 8) m_next = CP[(bh * 64 + c + 1) * 4];
        bf16x8_t cv[8]; v2u vlo[2][2], vhi[2][2];
#pragma unroll
        for (int ks = 0; ks < 8; ++ks) cv[ks] = ncv[ks];
#pragma unroll
        for (int st = 0; st < 2; ++st)
#pragma unroll
            for (int sp = 0; sp < 2; ++sp) { vlo[st][sp] = nvlo[st][sp]; vhi[st][sp] = nvhi[st][sp]; }
        if (i + 1 < 8) MO_PRIV(c + 1);
        v2u og[2][4];
#pragma unroll
        for (int tt = 0; tt < 2; ++tt)
#pragma unroll
            for (int rg = 0; rg < 4; ++rg) og[tt][rg] = *(const GAS v2u*)(uf_piece(UF, (int)row0 + 32 * tt + r, 2048 + hh * 256 + 32 * w + 8 * rg + 4 * hi) + 4 * hi);
        f32x16 hv[2]; float dn[2];
#pragma unroll
        for (int tt = 0; tt < 2; ++tt) {
            const int t = 32 * tt + r; const float mx_t = fmaxf(m_prev, SP[t]), u_t = -mx_t, mt_t = SB[t] + mx_t;
            bf16x8_t qf[8];
#pragma unroll
            for (int ks = 0; ks < 8; ++ks) qf[ks] = *(const LAS bf16x8_t*)(S + (tt * 8 + ks) * 1024 + F.lane * 16);
            if (w == tt) {
                f32x16 accn;
#pragma unroll
                for (int q = 0; q < 16; ++q) accn[q] = 0.f;
#pragma unroll
                for (int g4 = 0; g4 < 2; ++g4) {
                    bf16x8_t nf[4];
#pragma unroll
                    for (int k = 0; k < 4; ++k) nf[k] = *(const LAS bf16x8_t*)(S + (32 + 4 * g4 + k) * 1024 + F.lane * 16);
                    __builtin_amdgcn_sched_group_barrier(0x100, 4, 0);
#pragma unroll
                    for (int k = 0; k < 4; ++k) accn = MFMA32(nf[k], qf[4 * g4 + k], accn);
                    __builtin_amdgcn_sched_group_barrier(0x008, 4, 0);
                }
                if (hi == 0) qnl[par * 64 + t] = accn[0];
            }
            __builtin_amdgcn_sched_barrier(0);
            f32x16 acc; float den = 0.f;
#pragma unroll
            for (int q = 0; q < 16; ++q) acc[q] = 0.f;
#pragma unroll
            for (int st = 0; st <= tt; ++st) {
                __builtin_amdgcn_sched_barrier(0);
                f32x16 X;
#pragma unroll
                for (int q = 0; q < 16; ++q) X[q] = 0.f;
#pragma unroll
                for (int g4 = 0; g4 < 2; ++g4) {
                    bf16x8_t kf[4];
#pragma unroll
                    for (int k = 0; k < 4; ++k) kf[k] = *(const LAS bf16x8_t*)(S + (16 + st * 8 + 4 * g4 + k) * 1024 + F.lane * 16);
                    __builtin_amdgcn_sched_group_barrier(0x100, 4, 0);
#pragma unroll
                    for (int k = 0; k < 4; ++k) X = MFMA32(kf[k], qf[4 * g4 + k], X);
                    __builtin_amdgcn_sched_group_barrier(0x008, 4, 0);
                }
#pragma unroll
                for (int rg = 0; rg < 4; ++rg) { const f32x4 av = *(const LAS f32x4*)(SA + 32 * st + 8 * rg + 4 * hi);
#pragma unroll
                    for (int e = 0; e < 4; ++e) { const int s = 32 * st + 8 * rg + 4 * hi + e; const float val = (s <= t) ? X[4 * rg + e] * __expf(u_t + av[e]) : 0.f; X[4 * rg + e] = val; den += val; } }
#pragma unroll
                for (int sp = 0; sp < 2; ++sp) {
                    const bf16x8_t pf = mk_frag(cvtpk(X[8 * sp], X[8 * sp + 1]), cvtpk(X[8 * sp + 2], X[8 * sp + 3]), cvtpk(X[8 * sp + 4], X[8 * sp + 5]), cvtpk(X[8 * sp + 6], X[8 * sp + 7]));
                    acc = MFMA32(mk_frag(vlo[st][sp].x, vlo[st][sp].y, vhi[st][sp].x, vhi[st][sp].y), pf, acc);
                }
            }
            __builtin_amdgcn_sched_barrier(0);
            const float is = __expf(u_t + m_prev);
            f32x16 acc2;
#pragma unroll
            for (int q = 0; q < 16; ++q) acc2[q] = 0.f;
#pragma unroll
            for (int ks = 0; ks < 8; ++ks) acc2 = MFMA32(cv[ks], qf[ks], acc2);
            __builtin_amdgcn_sched_barrier(0);
            den = xh_sum(den);
            dn[tt] = den;
            float ssq = 0.f;
#pragma unroll
            for (int q = 0; q < 16; ++q) { const float h = acc[q] + is * acc2[q]; hv[tt][q] = h; ssq += h * h; }
            ssq = xh_sum(ssq);
            if (hi == 0) part[(par * 8 + w) * 64 + t] = ssq;
        }
        asm volatile("s_waitcnt lgkmcnt(0)" ::: "memory"); __builtin_amdgcn_s_barrier(); asm volatile("" ::: "memory");
#pragma unroll
        for (int tt = 0; tt < 2; ++tt) {
            const int t = 32 * tt + r; float tot = 0.f;
#pragma unroll
            for (int ww = 0; ww < 8; ++ww) tot += part[(par * 8 + ww) * 64 + t];
            const float mx_t = fmaxf(m_prev, SP[t]); const float inv = 1.0f / fmaxf(fabsf(dn[tt] + __expf(m_prev - mx_t) * qnl[par * 64 + t]), __expf(-(SB[t] + mx_t)));
            const float rs = inv / sqrtf(tot * inv * inv * (1.0f / 256.0f) + EPS);
            const int row = (int)row0 + t;
            unsigned P[8];
#pragma unroll
            for (int rg = 0; rg < 4; ++rg) { const int v0 = hh * 256 + 32 * w + 8 * rg + 4 * hi;
                const f32x4 g4 = *(const LAS f32x4*)(mhl + 32 * w + 8 * rg + 4 * hi); const v2u ow = og[tt][rg];
                const float y0 = hv[tt][4 * rg] * rs * g4.x * __builtin_amdgcn_rcpf(1.0f + __expf(-bflo(ow.x))), y1 = hv[tt][4 * rg + 1] * rs * g4.y * __builtin_amdgcn_rcpf(1.0f + __expf(-bfhi(ow.x)));
                const float y2 = hv[tt][4 * rg + 2] * rs * g4.z * __builtin_amdgcn_rcpf(1.0f + __expf(-bflo(ow.y))), y3 = hv[tt][4 * rg + 3] * rs * g4.w * __builtin_amdgcn_rcpf(1.0f + __expf(-bfhi(ow.y)));
                if constexpr (H8) P[rg] = pg8::pk4_f8(y0 * X_SCALE, y1 * X_SCALE, y2 * X_SCALE, y3 * X_SCALE); else { P[2 * rg] = cvtpk(y0, y1); P[2 * rg + 1] = cvtpk(y2, y3); } }
            if constexpr (H8) {
                const auto s0 = __builtin_amdgcn_permlane32_swap(P[0], P[2], false, false), s1 = __builtin_amdgcn_permlane32_swap(P[1], P[3], false, false);
                *(GAS v4u*)((unsigned char*)HM + (size_t)row * D + hh * 256 + 32 * w + 16 * hi) = (v4u){s0[0], s0[1], s1[0], s1[1]};
            } else {
            const auto s0 = __builtin_amdgcn_permlane32_swap(P[0], P[4], false, false), s1 = __builtin_amdgcn_permlane32_swap(P[1], P[5], false, false);
            const auto s2 = __builtin_amdgcn_permlane32_swap(P[2], P[6], false, false), s3 = __builtin_amdgcn_permlane32_swap(P[3], P[7], false, false);
            GAS v4u* dst = (GAS v4u*)(HM + (size_t)row * D + hh * 256 + 32 * w + 16 * hi);
            dst[0] = (v4u){s0[0], s1[0], s0[1], s1[1]}; dst[1] = (v4u){s2[0], s3[0], s2[1], s3[1]}; }
        }
        par ^= 1;
    }
#undef MO_PRIV
    asm volatile("s_waitcnt vmcnt(0)" ::: "memory"); __syncthreads();
}
__device__ __forceinline__ void attn_prep(Frame& F) {
    const bf16* UF = (const bf16*)(F.ws + WS_U); bf16* VTF = (bf16*)(F.ws + WS_VTA);
    const int bi = F.tid >> 6, l = F.lane;
    const int st = 32 * (bi & 1) + (l & 31), sd = 16 * (bi >> 1) + 8 * (l >> 5);
    const int odt = bi & 1, otk = bi >> 1, od = 32 * odt + (l & 31), ot = 16 * otk + 8 * (l >> 5);
    v4u cur = (v4u){0u, 0u, 0u, 0u};
    { const int un = F.wg; const int b = un >> 10, h16 = (un >> 6) & 15, tb = un & 63; const int vcb = (h16 < 8 ? 1024 + 64 * h16 : 2560 + 64 * (h16 - 8)) >> 4;
      cur = *(const GAS v4u*)(uf_block(UF, vcb + (bi >> 1), b * 128 + 2 * tb + (bi & 1)) + l * 8); }
    int buf = 0;
    for (int un = F.wg; un < 8192; un += F.G) {
        const int b = un >> 10, h16 = (un >> 6) & 15, tb = un & 63;
        LAS unsigned char* tile = F.lds + buf * 9216;
        *(LAS v4u*)(tile + st * 144 + sd * 2) = cur;
        const int nx = un + F.G;
        if (nx < 8192) { const int b2 = nx >> 10, h2 = (nx >> 6) & 15, tb2 = nx & 63; const int vcb = (h2 < 8 ? 1024 + 64 * h2 : 2560 + 64 * (h2 - 8)) >> 4;
            cur = *(const GAS v4u*)(uf_block(UF, vcb + (bi >> 1), b2 * 128 + 2 * tb2 + (bi & 1)) + l * 8); }
        __syncthreads();
        unsigned w[4];
#pragma unroll
        for (int i = 0; i < 4; ++i) { const unsigned lo = *(const LAS unsigned short*)(tile + (ot + 2 * i) * 144 + od * 2), hi = *(const LAS unsigned short*)(tile + (ot + 2 * i + 1) * 144 + od * 2); w[i] = lo | (hi << 16); }
        *(GAS v4u*)(VTF + ((((size_t)b * 16 + h16) * 2 + odt) * 256 + 4 * tb + otk) * 512 + l * 8) = (v4u){w[0], w[1], w[2], w[3]};
        buf ^= 1;
    }
    __syncthreads();
}
struct VFrag { v2u lo[2][2], hi[2][2]; };
__device__ __forceinline__ void load_v(VFrag& v, const bf16* vtf, int r, int hi) {
#pragma unroll
    for (int sp = 0; sp < 2; ++sp)
#pragma unroll
        for (int dt = 0; dt < 2; ++dt) { const bf16* blk = vtf + ((size_t)dt * 256 + sp) * 512; v.lo[sp][dt] = *(const GAS v2u*)(blk + r * 8 + 4 * hi); v.hi[sp][dt] = *(const GAS v2u*)(blk + (r + 32) * 8 + 4 * hi); }
}
__device__ __forceinline__ void pv_tile(f32x16 (&oacc)[2], const float (&p)[16], const VFrag& v) {
#pragma unroll
    for (int sp = 0; sp < 2; ++sp) {
        const bf16x8_t pf = mk_frag(cvtpk(p[8 * sp], p[8 * sp + 1]), cvtpk(p[8 * sp + 2], p[8 * sp + 3]), cvtpk(p[8 * sp + 4], p[8 * sp + 5]), cvtpk(p[8 * sp + 6], p[8 * sp + 7]));
#pragma unroll
        for (int dt = 0; dt < 2; ++dt) oacc[dt] = MFMA32(mk_frag(v.lo[sp][dt].x, v.lo[sp][dt].y, v.hi[sp][dt].x, v.hi[sp][dt].y), pf, oacc[dt]);
    }
}
template <bool O8> __device__ __forceinline__ void store_ot(bf16* orow  , const f32x16 (&oacc)[2], float scale) {
    if constexpr (O8) {
#pragma unroll
        for (int dt = 0; dt < 2; ++dt) { unsigned Q[4]; const float sc = scale * X_SCALE;
#pragma unroll
            for (int g = 0; g < 4; ++g) Q[g] = pg8::pk4_f8(oacc[dt][4 * g] * sc, oacc[dt][4 * g + 1] * sc, oacc[dt][4 * g + 2] * sc, oacc[dt][4 * g + 3] * sc);
            const auto s0 = __builtin_amdgcn_permlane32_swap(Q[0], Q[2], false, false), s1 = __builtin_amdgcn_permlane32_swap(Q[1], Q[3], false, false);
            *(GAS v4u*)((unsigned char*)orow + 32 * dt) = (v4u){s0[0], s0[1], s1[0], s1[1]}; }
        return;
    }
#pragma unroll
    for (int dt = 0; dt < 2; ++dt) { unsigned P[8];
#pragma unroll
        for (int g = 0; g < 8; ++g) P[g] = cvtpk(oacc[dt][2 * g] * scale, oacc[dt][2 * g + 1] * scale);
        const auto s0 = __builtin_amdgcn_permlane32_swap(P[0], P[4], false, false), s1 = __builtin_amdgcn_permlane32_swap(P[1], P[5], false, false);
        const auto s2 = __builtin_amdgcn_permlane32_swap(P[2], P[6], false, false), s3 = __builtin_amdgcn_permlane32_swap(P[3], P[7], false, false);
        GAS v4u* dst = (GAS v4u*)(orow + 32 * dt);
        dst[0] = (v4u){s0[0], s1[0], s0[1], s1[1]}; dst[1] = (v4u){s2[0], s3[0], s2[1], s3[1]}; }
}
constexpr float ATT_C2 = 0.125f * 1.4426950408889634f;
template <bool MASKED> __device__ __forceinline__ void sb_weights(const f32x16& X, int kt, int t, int hi, int lane, float& run, float (&p)[16]) {
    float lb[16], la[16], G[4];
#pragma unroll
    for (int rg = 0; rg < 4; ++rg) { float g = 0.f;
#pragma unroll
        for (int e = 0; e < 4; ++e) { const int q = 4 * rg + e; const float z = X[q] * ATT_C2;
            const float sp = fmaxf(z, 0.f) + __builtin_amdgcn_logf(1.0f + __builtin_amdgcn_exp2f(-fabsf(z)));
            if (MASKED) { const int s_ = 32 * kt + 8 * rg + 4 * hi + e; const bool valid = s_ < t; lb[q] = valid ? -sp : 0.f; la[q] = valid ? z - sp : -INFINITY; }
            else { lb[q] = -sp; la[q] = z - sp; }
            g += lb[q]; }
        G[rg] = g; }
    float Go[4];
#pragma unroll
    for (int rg = 0; rg < 4; ++rg) Go[rg] = xh_other(G[rg], hi);
    float suf = run;
#pragma unroll
    for (int rg = 3; rg >= 0; --rg) {
        const float above = suf + (hi == 0 ? Go[rg] : 0.f);
        float inner = 0.f;
#pragma unroll
        for (int e = 3; e >= 0; --e) { const int q = 4 * rg + e; p[q] = __builtin_amdgcn_exp2f(la[q] + above + inner); inner += lb[q]; }
        suf += G[rg] + Go[rg];
    }
    run = suf;
}
template <bool O8> __device__ __forceinline__ void attn_mfma(Frame& F, const float* relb  ) {
    const bf16* UF = (const bf16*)(F.ws + WS_U); const bf16* VTF = (const bf16*)(F.ws + WS_VTA); bf16* O = (bf16*)(F.ws + WS_O);
    LAS float* bl = (LAS float*)(F.lds + F.wave * 2304);
    const int gw = F.vwg * NWAVES + F.wave, bh = gw >> 5, sub = gw & 31, b = bh >> 3, h = bh & 7, r = F.lane & 31, hi = F.lane >> 5;
    const size_t rowbase = (size_t)b * SEQ;
    for (int i = F.lane; i < 513; i += 64) bl[i] = relb[h * 513 + i] * 1.4426950408889634f;
    LDS_WAIT(); asm volatile("" ::: "memory");
    for (int uu = 0; uu < 4; ++uu) {
        const int qt = 4 * sub + uu, t = 32 * qt + r;
        bf16x8_t qf[4];
#pragma unroll
        for (int ks = 0; ks < 4; ++ks) qf[ks] = *(const GAS bf16x8_t*)(uf_block(UF, 4 * h + ks, b * 128 + qt) + F.lane * 8);
        f32x16 oacc[2];
#pragma unroll
        for (int q = 0; q < 16; ++q) { oacc[0][q] = 0.f; oacc[1][q] = 0.f; }
        float run = 0.f;
        const bf16* vt0 = VTF + (((size_t)b * 16 + h) * 2) * 256 * 512;
        bf16x8_t kn[4];
#pragma unroll
        for (int ks = 0; ks < 4; ++ks) kn[ks] = *(const GAS bf16x8_t*)(uf_block(UF, 32 + 4 * h + ks, b * 128 + qt) + F.lane * 8);
        for (int kt = qt; kt >= 0; --kt) {
            bf16x8_t kf[4]; VFrag vf;
#pragma unroll
            for (int ks = 0; ks < 4; ++ks) kf[ks] = kn[ks];
            load_v(vf, vt0 + (size_t)(2 * kt) * 512, r, hi);
            if (kt > 0) {
#pragma unroll
                for (int ks = 0; ks < 4; ++ks) kn[ks] = *(const GAS bf16x8_t*)(uf_block(UF, 32 + 4 * h + ks, b * 128 + kt - 1) + F.lane * 8); }
            f32x16 X;
#pragma unroll
            for (int q = 0; q < 16; ++q) X[q] = 0.f;
#pragma unroll
            for (int ks = 0; ks < 4; ++ks) X = MFMA32(kf[ks], qf[ks], X);
            float p[16];
            if (kt == qt) sb_weights<true>(X, kt, t, hi, F.lane, run, p); else sb_weights<false>(X, kt, t, hi, F.lane, run, p);
            pv_tile(oacc, p, vf);
            if (__all(run < -158.7f)) break;
        }
        store_ot<O8>(O8 ? (bf16*)((unsigned char*)O + (rowbase + t) * D + h * 64 + 16 * hi) : O + (rowbase + t) * D + h * 64 + 16 * hi, oacc, 1.0f);
    }
    for (int uu = 0; uu < 2; ++uu) {
        const int c = 2 * sub + uu, tA = 64 * c + r, tB = tA + 32;
        bf16x8_t qa[4], qb[4];
#pragma unroll
        for (int ks = 0; ks < 4; ++ks) { qa[ks] = *(const GAS bf16x8_t*)(uf_block(UF, 96 + 4 * h + ks, b * 128 + 2 * c) + F.lane * 8); qb[ks] = *(const GAS bf16x8_t*)(uf_block(UF, 96 + 4 * h + ks, b * 128 + 2 * c + 1) + F.lane * 8); }
        f32x16 oa[2], ob[2];
#pragma unroll
        for (int q = 0; q < 16; ++q) { oa[0][q] = 0.f; oa[1][q] = 0.f; ob[0][q] = 0.f; ob[1][q] = 0.f; }
        float ma = -INFINITY, la = 0.f, mb = -INFINITY, lb2 = 0.f;
        const bf16* vt0 = VTF + (((size_t)b * 16 + 8 + h) * 2) * 256 * 512;
        const int kt0 = (c >= 8) ? 2 * (c - 8) : 0;
        bf16x8_t kn[4];
#pragma unroll
        for (int ks = 0; ks < 4; ++ks) kn[ks] = *(const GAS bf16x8_t*)(uf_block(UF, 128 + 4 * h + ks, b * 128 + kt0) + F.lane * 8);
        for (int kt = kt0; kt <= 2 * c + 1; ++kt) {
            bf16x8_t kf[4]; VFrag vf;
#pragma unroll
            for (int ks = 0; ks < 4; ++ks) kf[ks] = kn[ks];
            load_v(vf, vt0 + (size_t)(2 * kt) * 512, r, hi);
            if (kt < 2 * c + 1) {
#pragma unroll
                for (int ks = 0; ks < 4; ++ks) kn[ks] = *(const GAS bf16x8_t*)(uf_block(UF, 128 + 4 * h + ks, b * 128 + kt + 1) + F.lane * 8); }
            f32x16 XA, XB;
#pragma unroll
            for (int q = 0; q < 16; ++q) { XA[q] = 0.f; XB[q] = 0.f; }
#pragma unroll
            for (int ks = 0; ks < 4; ++ks) { XA = MFMA32(kf[ks], qa[ks], XA); XB = MFMA32(kf[ks], qb[ks], XB); }
            float xa[16], xb[16]; float mxa = -INFINITY, mxb = -INFINITY;
            if (kt <= 2 * c - 9) {
                const float bfar = bl[512];
#pragma unroll
                for (int q = 0; q < 16; ++q) { xa[q] = XA[q] * ATT_C2 + bfar; mxa = fmaxf(mxa, xa[q]); xb[q] = XB[q] * ATT_C2 + bfar; mxb = fmaxf(mxb, xb[q]); }
            } else {
#pragma unroll
                for (int q = 0; q < 16; ++q) { const int s = 32 * kt + (q & 3) + 8 * (q >> 2) + 4 * hi; int ra = tA - s; ra = ra < -256 ? -256 : (ra > 256 ? 256 : ra); int rb = tB - s; rb = rb < -256 ? -256 : (rb > 256 ? 256 : rb);
                    xa[q] = XA[q] * ATT_C2 + bl[ra + 256]; mxa = fmaxf(mxa, xa[q]); xb[q] = XB[q] * ATT_C2 + bl[rb + 256]; mxb = fmaxf(mxb, xb[q]); }
            }
            mxa = xh_max(mxa); mxb = xh_max(mxb);
            if (__any(mxa > ma + 8.0f || mxb > mb + 8.0f)) {
                const float mna = fmaxf(ma, mxa), ala = __builtin_amdgcn_exp2f(ma - mna), mnb = fmaxf(mb, mxb), alb = __builtin_amdgcn_exp2f(mb - mnb); ma = mna; mb = mnb;
                la *= ala; lb2 *= alb;
#pragma unroll
                for (int q = 0; q < 16; ++q) { oa[0][q] *= ala; oa[1][q] *= ala; ob[0][q] *= alb; ob[1][q] *= alb; }
            }
            float pa[16], pb[16]; float psa = 0.f, psb = 0.f;
#pragma unroll
            for (int q = 0; q < 16; ++q) { pa[q] = __builtin_amdgcn_exp2f(xa[q] - ma); psa += pa[q]; pb[q] = __builtin_amdgcn_exp2f(xb[q] - mb); psb += pb[q]; }
            psa = xh_sum(psa); psb = xh_sum(psb);
            la += psa; lb2 += psb;
            pv_tile(oa, pa, vf); pv_tile(ob, pb, vf);
        }
        store_ot<O8>(O8 ? (bf16*)((unsigned char*)O + (rowbase + tA) * D + 512 + h * 64 + 16 * hi) : O + (rowbase + tA) * D + 512 + h * 64 + 16 * hi, oa, 1.0f / la);
        store_ot<O8>(O8 ? (bf16*)((unsigned char*)O + (rowbase + tB) * D + 512 + h * 64 + 16 * hi) : O + (rowbase + tB) * D + 512 + h * 64 + 16 * hi, ob, 1.0f / lb2);
    }
}

struct Args { const float* in[23]; float* out; unsigned char* ws; int ph_lo, ph_hi, li, pad; };
#if MK_PER_PHASE
#define IN(k) (lo <= (k) && (k) < hi)
#else
#define IN(k) true
#endif
#define INP(i) ((const float*)ldptr(F, (i)))
#define HOUT ((float*)ldptr(F, 23))
#define H ((bf16*)(F.ws + WS_HB))
#define SEAM(k) do { if (IN(k) && IN((k) + 1)) xcd_barrier(bar); RELANE(); } while (0)
#define RELANE() do { int t_ = threadIdx.x; asm volatile("" : "+v"(t_)); F.tid = t_; F.lane = t_ & 63; F.wave = __builtin_amdgcn_readfirstlane(t_ >> 6); } while (0)
template <int j> __device__ __forceinline__ void layer_pair(Frame& F, const XcdBarrier& bar, const int lo, const int hi) {
    bf16* XN = (bf16*)(F.ws + WS_XN);
    LAS unsigned char* ring = F.lds;
        const int pb = j * NPH_PAIR;
        constexpr bool F8D = (j == 1) && DENSE_F8_L2, L8 = (j == 1) && LATE_F8, LQ = L8 && LATE_QKV, LI = L8 && LATE_INP, LO = L8 && LATE_OUT; constexpr float L8S = 1.0f / (X_SCALE * W_GU_SCALE);
        if (IN(pb + 0)) {
            if (j == 0) { convert_even<F8D, LQ, LO>(F, INP(2) + (size_t)j * D * NQKV, INP(4) + (size_t)j * D * D, INP(6) + (size_t)j * D * DFF, INP(7) + (size_t)j * D * DFF, INP(8) + (size_t)j * DFF * D);
            __syncthreads(); }
            if (j == 0) norm_phase<false, 0, false, true>(F, INP(0), H, INP(1), XN, nullptr, nullptr, nullptr, nullptr);
            else        norm_phase<true, 0, LQ>(F, H, H, INP(1) + D, XN, nullptr, nullptr, nullptr, nullptr);
        }
        SEAM(pb + 0);
        if (IN(pb + 1)) {
            pg8::Gemm g{XN, (const bf16*)(F.ws + WS_WQKV), T, NQKV, LQ ? D / 2 : D};
            { typedef pg8::LutOrder<0x98763210ull, 8> QK; QK S; S.init(T, F.G, F.wg);
              pg8::EpiStoreTiled E{(bf16*)(F.ws + WS_U), T / 32, LQ ? L8S : 1.0f};
              pg8::gemm_phase<pg8::EpiStoreTiled, QK, true, true, LQ>(ring, g, S, E); }
            { typedef pg8::LutOrder<0xBA54ull, 4> VV; VV S; S.init(T, F.G, F.wg);
              pg8::EpiStoreVT<false> E{(bf16*)(F.ws + WS_VTA), LQ ? L8S : 1.0f};
              pg8::gemm_phase<pg8::EpiStoreVT<false>, VV, true, true, LQ, true>(ring, g, S, E); }
        }
        SEAM(pb + 1);
        if (IN(pb + 3)) { attn_mfma<LO>(F, INP(3) + (size_t)j * 8 * 513); }
        SEAM(pb + 3);
        if (IN(pb + 4)) {
            pg8::Gemm g{(const bf16*)(F.ws + WS_O), (const bf16*)(F.ws + WS_WO), T, D, LO ? D / 2 : D}; pg8::StaticOrder S; S.init(T, D, F.G, F.wg);
            pg8::EpiResidH<j == 0> E{j == 0 ? (const void*)INP(0) : (const void*)H, H, D, LO ? L8S : 1.0f};
            pg8::gemm_phase<pg8::EpiResidH<j == 0>, pg8::StaticOrder, true, true, LO>(ring, g, S, E);
        }
        SEAM(pb + 4);
        if (IN(pb + 5)) { norm_phase<false, F8D ? 4 : 0>(F, H, H, INP(5) + (size_t)j * D, XN, nullptr, nullptr, nullptr, nullptr); }
        SEAM(pb + 5);
        if (IN(pb + 6)) {
            pg8::StaticOrder S; S.init(T, 2 * DFF, F.G, F.wg);
            if constexpr (F8D) {
                pg8::Gemm g{XN, (const bf16*)(F.ws + WS_WGU), T, 2 * DFF, D / 2};
                pg8::EpiSwiGLUF8 E{F.ws + WS_ACT, DFF, 1.0f / (X_SCALE * W_GU_SCALE), ACT_SCALE};
                pg8::gemm_phase<pg8::EpiSwiGLUF8, pg8::StaticOrder, true, true, true>(ring, g, S, E);
            } else {
                pg8::Gemm g{XN, (const bf16*)(F.ws + WS_WGU), T, 2 * DFF, D};
                pg8::EpiSwiGLU E{(bf16*)(F.ws + WS_ACT), DFF};
                pg8::gemm_phase<pg8::EpiSwiGLU, pg8::StaticOrder, true, true>(ring, g, S, E);
            }
        }
        SEAM(pb + 6);
        if (IN(pb + 7)) {
            pg8::StaticOrder S; S.init(T, D, F.G, F.wg);
            if constexpr (F8D) {
                pg8::Gemm g{(const bf16*)(F.ws + WS_ACT), (const bf16*)(F.ws + WS_WD), T, D, DFF / 2};
                pg8::EpiResidH<false> E{H, H, D, 1.0f / (ACT_SCALE * W_D_SCALE)};
                pg8::gemm_phase<pg8::EpiResidH<false>, pg8::StaticOrder, true, true, true>(ring, g, S, E);
            } else {
                pg8::Gemm g{(const bf16*)(F.ws + WS_ACT), (const bf16*)(F.ws + WS_WD), T, D, DFF};
                pg8::EpiResidH<false> E{H, H, D, 1.0f};
                pg8::gemm_phase<pg8::EpiResidH<false>, pg8::StaticOrder, true, true>(ring, g, S, E);
            }
        }
        SEAM(pb + 7);
        if (IN(pb + 8)) {
            convert_odd<LI, LO>(F, INP(10) + (size_t)j * D * MLW, INP(16) + (size_t)j * D * D, INP(19) + (size_t)j * NEXP * D * DFFE, INP(20) + (size_t)j * NEXP * D * DFFE, INP(21) + (size_t)j * NEXP * DFFE * D);
            __syncthreads();
            norm_phase<false, 1, LI>(F, H, H, INP(9) + (size_t)j * D, XN, nullptr, INP(10) + (size_t)j * D * MLW, INP(13) + j * 4, INP(14) + j * 4);
        }
        SEAM(pb + 8);
        if (IN(pb + 9)) {
            mlstm_scalars(F); __syncthreads();
            pg8::Gemm g{XN, (const bf16*)(F.ws + WS_WIN), T, NQKV, LI ? D / 2 : D};
            { typedef pg8::LutOrder<0xBA983210ull, 8> QO; QO S; S.init(T, F.G, F.wg);
              pg8::EpiStoreTiled E{(bf16*)(F.ws + WS_U), T / 32, LI ? L8S : 1.0f};
              pg8::gemm_phase<pg8::EpiStoreTiled, QO, true, true, LI>(ring, g, S, E); }
            { typedef pg8::LutOrder<0x7654ull, 4> VV; VV S; S.init(T, F.G, F.wg);
              pg8::EpiStoreVT<true> E{(bf16*)(F.ws + WS_VT), LI ? L8S : 1.0f};
              pg8::gemm_phase<pg8::EpiStoreVT<true>, VV, true, true, LI, true>(ring, g, S, E); }
        }
        SEAM(pb + 9);
        if (IN(pb + 10)) { mlstm_prep(F, INP(11) + (size_t)j * 4 * D, INP(12) + (size_t)j * D); }
        SEAM(pb + 10);
        if (IN(pb + 11)) { mlstm_state(F, INP(11) + (size_t)j * 4 * D, INP(12) + (size_t)j * D); }
        SEAM(pb + 11);
        if (IN(pb + 12)) { mlstm_out<LO>(F, INP(15) + (size_t)j * D); }
        SEAM(pb + 12);
        if (IN(pb + 13)) {
            pg8::Gemm g{(const bf16*)(F.ws + WS_HM), (const bf16*)(F.ws + WS_WO), T, D, LO ? D / 2 : D}; pg8::StaticOrder S; S.init(T, D, F.G, F.wg);
            pg8::EpiResidH<false> E{H, H, D, LO ? L8S : 1.0f};
            pg8::gemm_phase<pg8::EpiResidH<false>, pg8::StaticOrder, true, true, LO>(ring, g, S, E);
        }
        SEAM(pb + 13);
        if (IN(pb + 14)) { norm_phase<false, 2, true>(F, H, H, INP(17) + (size_t)j * D, XN, nullptr, INP(18) + (size_t)j * D * NEXP, nullptr, nullptr); }
        SEAM(pb + 14);
        if (IN(pb + 15)) { moe_assign_gather(F); }
        SEAM(pb + 15);
        if (IN(pb + 16)) {
            const int nt = moe_tile_table(F);
            pg8::Gemm g{(const bf16*)(F.ws + WS_XG), (const bf16*)(F.ws + WS_WEGU), 0, 0, D / 2};
            pg8::MoeOrder S{nt, 28, F.G, F.wg, 0, (const LAS int*)(F.lds + L_TEXP)};
            pg8::EpiSwiGLUF8 E{F.ws + WS_ACTM, DFFE, 1.0f / (X_SCALE * W_GU_SCALE), ACT_SCALE};
            pg8::gemm_phase<pg8::EpiSwiGLUF8, pg8::MoeOrder, true, true, true>(ring, g, S, E);
        }
        SEAM(pb + 16);
        if (IN(pb + 17)) {
            const int nt = moe_tile_table(F);
            pg8::Gemm g{(const bf16*)(F.ws + WS_ACTM), (const bf16*)(F.ws + WS_WED), 0, 0, DFFE / 2};
            pg8::MoeOrder S{nt, 4, F.G, F.wg, 0, (const LAS int*)(F.lds + L_TEXP)};
            pg8::EpiStoreBf16S E{(bf16*)(F.ws + WS_Y), D, 1.0f / (ACT_SCALE * W_D_SCALE)};
            pg8::gemm_phase<pg8::EpiStoreBf16S, pg8::MoeOrder, true, true, true>(ring, g, S, E);
            if (j == 0) {
                constexpr bool F8Dn = DENSE_F8_L2 != 0, L8n = LATE_F8 != 0, LQn = L8n && LATE_QKV, LOn = L8n && LATE_OUT;
                int extra = nt * 4 - 4 * F.G; extra = extra < 0 ? 0 : (extra > F.G / 2 ? F.G / 2 : extra);
                __syncthreads();
                convert_even<F8Dn, LQn, LOn>(F, INP(2) + (size_t)1 * D * NQKV, INP(4) + (size_t)1 * D * D, INP(6) + (size_t)1 * D * DFF, INP(7) + (size_t)1 * D * DFF, INP(8) + (size_t)1 * DFF * D, extra);
            }
        }
        SEAM(pb + 17);
}

__global__ void __launch_bounds__(NTHREADS, 2) fwd_kernel(Args args) {
    extern __shared__ __attribute__((aligned(16))) unsigned char lds[];
    Frame F;
    F.lds = (LAS unsigned char*)lds; F.MISC = (volatile LAS unsigned*)(F.lds + L_MISC);
    F.tid = threadIdx.x; F.lane = F.tid & 63; F.wave = __builtin_amdgcn_readfirstlane(F.tid >> 6); F.wg = blockIdx.x; F.G = gridDim.x; F.ws = args.ws; F.vwg = (F.G % 8 == 0) ? (F.wg % 8) * (F.G / 8) + F.wg / 8 : F.wg;
    for (int u = F.tid; u < (LDS_BYTES - LDSCTL_OFF) / 4; u += NTHREADS) ((LAS unsigned*)(F.lds + LDSCTL_OFF))[u] = 0u;
    __syncthreads();
    if (F.tid < 23) ((LAS unsigned long long*)(F.lds + L_PTR))[F.tid] = (unsigned long long)args.in[F.tid];
    if (F.tid == 23) ((LAS unsigned long long*)(F.lds + L_PTR))[23] = (unsigned long long)args.out;
    __syncthreads();
    const int lo = args.ph_lo, hi = args.ph_hi;
    gu32* ctl = (gu32*)(args.ws + WS_CTL);
    XcdBarrier bar; bar.bar = (unsigned*)(ctl + CW_BAR) + args.li * XCD_BAR_WORDS; bar.x = 0; bar.st = nullptr;
    if (hi - lo > 1) bar = xcd_barrier_post((unsigned*)(ctl + CW_BAR) + args.li * XCD_BAR_WORDS, F.MISC + 8);
    layer_pair<0>(F, bar, lo, hi);
    layer_pair<1>(F, bar, lo, hi);
    if (IN(2 * NPH_PAIR)) { norm_phase<true, 3>(F, H, H, INP(22), nullptr, HOUT, nullptr, nullptr, nullptr); }
#undef IN
#undef INP
#undef HOUT
#undef H
#undef SEAM
#undef RELANE
}

extern "C" void kernel_launch(void* const* d_in, const int* in_sizes, int n_in, void* d_out, int out_size, void* d_ws, size_t ws_size, hipStream_t stream) {
    static int grid = 0;
    if (grid == 0) {
        if (n_in != 23 || in_sizes[0] != T * D || out_size != T * D || ws_size < WS_END) { fprintf(stderr, "kernel_launch: unexpected shapes (n_in %d, in0 %d, out %d, ws %zu)\n", n_in, n_in > 0 ? in_sizes[0] : -1, out_size, ws_size); grid = -1; return; }
        int dev = 0, cus = 0, per_cu = 0;
        if (hipGetDevice(&dev) != hipSuccess || hipDeviceGetAttribute(&cus, hipDeviceAttributeMultiprocessorCount, dev) != hipSuccess) { grid = -1; return; }
        if (hipFuncSetAttribute((const void*)fwd_kernel, hipFuncAttributeMaxDynamicSharedMemorySize, LDS_BYTES) != hipSuccess) { fprintf(stderr, "kernel_launch: hipFuncSetAttribute failed\n"); grid = -1; return; }
        if (hipOccupancyMaxActiveBlocksPerMultiprocessor(&per_cu, (const void*)fwd_kernel, NTHREADS, LDS_BYTES) != hipSuccess || per_cu < 1) fprintf(stderr, "kernel_launch: occupancy query says %d\n", per_cu);
        (void)hipGetLastError();
        if (cus != 256) { fprintf(stderr, "kernel_launch: built for 256 CUs, found %d\n", cus); grid = -1; return; }
        grid = cus;
    }
    if (grid < 0) return;
    if (hipMemsetAsync((char*)d_ws + WS_CTL, 0, CTL_ZERO_BYTES, stream) != hipSuccess) return;
    Args a{};
    for (int i = 0; i < 23; ++i) a.in[i] = (const float*)d_in[i];
    a.out = (float*)d_out; a.ws = (unsigned char*)d_ws; a.pad = 0;
#if MK_PER_PHASE
    for (int p = 0; p < NPHASES; ++p) { a.ph_lo = p; a.ph_hi = p + 1; a.li = 0; hipLaunchKernelGGL(fwd_kernel, dim3(grid), dim3(NTHREADS), LDS_BYTES, stream, a); }
#else
    a.ph_lo = 0; a.ph_hi = NPHASES; a.li = 0;
    hipLaunchKernelGGL(fwd_kernel, dim3(grid), dim3(NTHREADS), LDS_BYTES, stream, a);
#endif
}
```
